# Optimizing an MI355X kernel written in HIP

```python
import math
import jax, jax.numpy as jnp
from jax import lax
import numpy as np

D_MODEL = 2048
BATCH = 4
SEQ = 8192
DEPTH = 1

S5_WIDTH = D_MODEL // 4
S5_GROUP = 16
S5_GROUPS = S5_WIDTH // S5_GROUP
S5_STATE = 64
N_DIR = 2
DT_MIN = 1e-3
DT_MAX = 1e-1
FNET_WIDTH = D_MODEL - S5_WIDTH
FNET_GROUP = 256
FNET_GROUPS = FNET_WIDTH // FNET_GROUP
IN_WIDTH = S5_WIDTH + FNET_WIDTH + 2 * D_MODEL
D_FF = -(-8 * D_MODEL // (3 * 256)) * 256
N_MOD = 6
EPS = 1e-6

kernel_name = "hybrid_s5_fnet_gated_encoder_block"


def rms_norm(x, g):
    xf = x.astype(jnp.float32)
    y = xf * lax.rsqrt(jnp.mean(xf * xf, axis=-1, keepdims=True) + EPS)
    return (y * g.astype(jnp.float32)).astype(x.dtype)


def modulate(h, shift, scale):
    return h * (1.0 + scale[:, None, :]) + shift[:, None, :]


def _complex_combine(left, right):
    a1r, a1i, b1r, b1i = left
    a2r, a2i, b2r, b2i = right
    ar = a2r * a1r - a2i * a1i
    ai = a2r * a1i + a2i * a1r
    br = a2r * b1r - a2i * b1i + b2r
    bi = a2r * b1i + a2i * b1r + b2i
    return ar, ai, br, bi


def s5_direction(u, lam_re, lam_im, log_step, b_re, b_im, c_re, c_im, reverse):
    dt = jnp.exp(log_step)[:, None]
    mag = jnp.exp(lam_re * dt)
    ang = lam_im * dt
    lb_re = mag * jnp.cos(ang)
    lb_im = mag * jnp.sin(ang)
    den = lam_re * lam_re + lam_im * lam_im
    num_re = lb_re - 1.0
    num_im = lb_im
    coef_re = (num_re * lam_re + num_im * lam_im) / den
    coef_im = (num_im * lam_re - num_re * lam_im) / den
    bb_re = coef_re[..., None] * b_re - coef_im[..., None] * b_im
    bb_im = coef_re[..., None] * b_im + coef_im[..., None] * b_re
    bu_re = jnp.einsum('bsgh,gnh->bsgn', u, bb_re)
    bu_im = jnp.einsum('bsgh,gnh->bsgn', u, bb_im)
    a_re = jnp.broadcast_to(lb_re, bu_re.shape)
    a_im = jnp.broadcast_to(lb_im, bu_im.shape)
    _, _, st_re, st_im = lax.associative_scan(
        _complex_combine, (a_re, a_im, bu_re, bu_im), axis=1, reverse=reverse)
    return (jnp.einsum('bsgn,ghn->bsgh', st_re, c_re)
            - jnp.einsum('bsgn,ghn->bsgh', st_im, c_im))


def s5_branch(u_in, lam_re, lam_im, log_step, b_re, b_im, c_re, c_im, d_skip, w_glu):
    bsz, seq, _ = u_in.shape
    u = u_in.astype(jnp.float32).reshape(bsz, seq, S5_GROUPS, S5_GROUP)
    f32 = lambda t: t.astype(jnp.float32)
    y = d_skip.astype(jnp.float32).reshape(S5_GROUPS, S5_GROUP) * u
    for d in range(N_DIR):
        y = y + s5_direction(u, f32(lam_re[d]), f32(lam_im[d]), f32(log_step[d]),
                             f32(b_re[d]), f32(b_im[d]), f32(c_re[d]), f32(c_im[d]),
                             reverse=(d == 1))
    y = jax.nn.gelu(y.reshape(bsz, seq, S5_WIDTH)).astype(u_in.dtype)
    val, gate = jnp.split(y @ w_glu, 2, axis=-1)
    return val * jax.nn.sigmoid(gate)


def fnet_branch(u_in):
    bsz, seq, _ = u_in.shape
    u = u_in.astype(jnp.float32).reshape(bsz, seq, FNET_GROUPS, FNET_GROUP)
    z = jnp.fft.fft2(u, axes=(1, 3), norm='ortho').real
    return z.reshape(bsz, seq, FNET_WIDTH).astype(u_in.dtype)


def setup_inputs(seed: int = 0) -> dict:
    key = jax.random.key(seed)
    ks = jax.random.split(key, 24)
    nrm = jax.random.normal

    def dense(k, shape, fan_in):
        return nrm(k, shape, jnp.float32) * (fan_in ** -0.5)

    L = DEPTH
    x = nrm(ks[0], (BATCH, SEQ, D_MODEL), jnp.float32)
    c = nrm(ks[1], (BATCH, D_MODEL), jnp.float32)
    w_ada = dense(ks[2], (L, D_MODEL, N_MOD * D_MODEL), D_MODEL)
    b_ada = 0.01 * nrm(ks[3], (L, N_MOD * D_MODEL), jnp.float32)
    norm_mix = 1.0 + 0.01 * nrm(ks[4], (L, D_MODEL), jnp.float32)
    w_in = dense(ks[5], (L, D_MODEL, IN_WIDTH), D_MODEL)
    sshape = (L, N_DIR, S5_GROUPS, S5_STATE)
    s5_lambda_re = -0.5 + 0.01 * nrm(ks[6], sshape, jnp.float32)
    s5_lambda_im = (jnp.pi * jnp.arange(S5_STATE, dtype=jnp.float32)
                    + 0.01 * nrm(ks[7], sshape, jnp.float32))
    s5_log_step = jax.random.uniform(ks[8], (L, N_DIR, S5_GROUPS), jnp.float32,
                                     math.log(DT_MIN), math.log(DT_MAX))
    bshape = (L, N_DIR, S5_GROUPS, S5_STATE, S5_GROUP)
    s5_b_re = dense(ks[9], bshape, 2 * S5_GROUP)
    s5_b_im = dense(ks[10], bshape, 2 * S5_GROUP)
    cshape = (L, N_DIR, S5_GROUPS, S5_GROUP, S5_STATE)
    s5_c_re = dense(ks[11], cshape, 2 * S5_STATE)
    s5_c_im = dense(ks[12], cshape, 2 * S5_STATE)
    s5_d = nrm(ks[13], (L, S5_WIDTH), jnp.float32)
    w_s5_glu = dense(ks[14], (L, S5_WIDTH, 2 * S5_WIDTH), S5_WIDTH)
    w_branch_s5 = dense(ks[15], (L, S5_WIDTH, D_MODEL), S5_WIDTH)
    w_branch_fnet = dense(ks[16], (L, FNET_WIDTH, D_MODEL), FNET_WIDTH)
    w_out = dense(ks[17], (L, D_MODEL, D_MODEL), D_MODEL)
    norm_ffn = 1.0 + 0.01 * nrm(ks[18], (L, D_MODEL), jnp.float32)
    w_ffn_in = dense(ks[19], (L, D_MODEL, 2 * D_FF), D_MODEL)
    w_ffn_out = dense(ks[20], (L, D_FF, D_MODEL), D_FF)
    norm_final = 1.0 + 0.01 * nrm(ks[21], (D_MODEL,), jnp.float32)
    return {"x": x, "c": c, "w_ada": w_ada, "b_ada": b_ada, "norm_mix": norm_mix,
            "w_in": w_in, "s5_lambda_re": s5_lambda_re, "s5_lambda_im": s5_lambda_im,
            "s5_log_step": s5_log_step, "s5_b_re": s5_b_re, "s5_b_im": s5_b_im,
            "s5_c_re": s5_c_re, "s5_c_im": s5_c_im, "s5_d": s5_d, "w_s5_glu": w_s5_glu,
            "w_branch_s5": w_branch_s5, "w_branch_fnet": w_branch_fnet, "w_out": w_out,
            "norm_ffn": norm_ffn, "w_ffn_in": w_ffn_in, "w_ffn_out": w_ffn_out,
            "norm_final": norm_final}


def reference(x, c, w_ada, b_ada, norm_mix, w_in, s5_lambda_re, s5_lambda_im, s5_log_step,
              s5_b_re, s5_b_im, s5_c_re, s5_c_im, s5_d, w_s5_glu, w_branch_s5, w_branch_fnet,
              w_out, norm_ffn, w_ffn_in, w_ffn_out, norm_final):
    c_act = jax.nn.silu(c)
    for l in range(DEPTH):
        mod = c_act @ w_ada[l] + b_ada[l]
        sh_m, sc_m, g_m, sh_f, sc_f, g_f = jnp.split(mod, N_MOD, axis=-1)

        h = modulate(rms_norm(x, norm_mix[l]), sh_m, sc_m)
        proj = h @ w_in[l]
        o1 = S5_WIDTH
        o2 = o1 + FNET_WIDTH
        o3 = o2 + D_MODEL
        y_s5 = s5_branch(proj[..., :o1], s5_lambda_re[l], s5_lambda_im[l], s5_log_step[l],
                         s5_b_re[l], s5_b_im[l], s5_c_re[l], s5_c_im[l], s5_d[l], w_s5_glu[l])
        y_fn = fnet_branch(proj[..., o1:o2])
        gate_s5 = jax.nn.sigmoid(proj[..., o2:o3])
        gate_fn = jax.nn.sigmoid(proj[..., o3:])
        merged = gate_s5 * (y_s5 @ w_branch_s5[l]) + gate_fn * (y_fn @ w_branch_fnet[l])
        x = x + g_m[:, None, :] * (merged @ w_out[l])

        h2 = modulate(rms_norm(x, norm_ffn[l]), sh_f, sc_f)
        a, b = jnp.split(h2 @ w_ffn_in[l], 2, axis=-1)
        x = x + g_f[:, None, :] * ((jax.nn.silu(a) * b) @ w_ffn_out[l])
    return rms_norm(x, norm_final)
```

```cpp
#include <hip/hip_runtime.h>
#include <hip/hip_cooperative_groups.h>
#include <cstdio>
namespace cg = cooperative_groups;

#ifndef ONE_LAUNCH
#define ONE_LAUNCH 1
#endif

#define LAS __attribute__((address_space(3)))
typedef unsigned short bf16_t;
typedef short bf16x8 __attribute__((ext_vector_type(8)));
typedef float f32x4 __attribute__((ext_vector_type(4)));
typedef float f32x2 __attribute__((ext_vector_type(2)));
typedef unsigned u32x4 __attribute__((ext_vector_type(4)));
typedef unsigned u32x2 __attribute__((ext_vector_type(2)));

constexpr int NTHR = 512;
constexpr int MTOK = 32768, DM = 2048, SEQ = 8192, NB = 4;
constexpr int DFF = 5632;
constexpr int LDS_STAGE = 131072;
constexpr int LDS_BYTES = LDS_STAGE + 16;
constexpr int NPH = 14;

constexpr size_t al256(size_t x) { return (x + 255) & ~(size_t)255; }
constexpr size_t WS_BAR   = 0;
constexpr size_t WS_MOD   = 16384;
constexpr size_t WS_VNYQ  = al256(WS_MOD + 4ull * 12288 * 4);
constexpr size_t WS_UNQ   = al256(WS_VNYQ + 4ull * 1536 * 4);
constexpr size_t WS_GW    = al256(WS_UNQ + 16ull * 1536 * 4);
constexpr size_t WS_BIAS  = al256(WS_GW + 4ull * 2048 * 4);
constexpr size_t WS_RSTD  = al256(WS_BIAS + 4ull * 11264 * 4);
constexpr size_t WS_SSQ   = al256(WS_RSTD + 32768ull * 4);
constexpr size_t WS_WIN   = al256(WS_SSQ + 32768ull * 32 * 4);
constexpr size_t WS_WGLU  = WS_WIN + 6144ull * 2048 * 2;
constexpr size_t WS_WBS5  = WS_WGLU + 1024ull * 512 * 2;
constexpr size_t WS_WBFN  = WS_WBS5 + 2048ull * 512 * 2;
constexpr size_t WS_WOUT  = WS_WBFN + 2048ull * 1536 * 2;
constexpr size_t WS_WFFI  = WS_WOUT + 2048ull * 2048 * 2;
constexpr size_t WS_WFFO  = WS_WFFI + 11264ull * 2048 * 2;
constexpr size_t WS_DFTM  = WS_WFFO + 2048ull * 5632 * 2;
constexpr size_t WS_MG    = WS_DFTM;
constexpr size_t WS_CDM   = WS_DFTM + 8192ull * 8192 * 2;
constexpr size_t WS_KTAB  = WS_CDM + 512ull * 512 * 2;
constexpr size_t WS_TOEP  = WS_KTAB + 2ull * 32 * 64 * 256 * 4;
constexpr size_t WS_BST   = WS_TOEP + 32ull * 512 * 768 * 2;
constexpr size_t WS_H     = WS_BST + 32ull * 256 * 512 * 2;
constexpr size_t WS_A5    = WS_H + 32768ull * 2048 * 2;
constexpr size_t WS_SST   = WS_A5 + 32ull * 1024 * 768 * 2;
constexpr size_t WS_V     = WS_SST + 32ull * 1024 * 256 * 4;
constexpr size_t WS_Y5    = WS_H;
constexpr size_t WS_YS5   = WS_V + 16384ull * 3072 * 2 + 32768ull * 4096 * 2 + 16384ull * 2048 * 2;
constexpr size_t WS_GATES = WS_V + 16384ull * 3072 * 2;
constexpr size_t WS_UT    = WS_GATES + 32768ull * 4096 * 2;
constexpr size_t WS_YFN   = WS_UT;
constexpr size_t WS_ACT   = WS_GATES;
constexpr size_t WS_CSW   = WS_UT + 1536ull * 32768 * 2;
constexpr size_t WS_PBUF  = WS_UT;
constexpr size_t WS_END   = WS_CSW + 2ull * 2048 * 1536 * 2;
static_assert(WS_END <= (1ull << 30), "workspace map must fit 1 GiB");
static_assert(WS_YS5 == WS_UT + 16384ull * 2048 * 2 && WS_YS5 + 32768ull * 512 * 2 <= WS_CSW, "YS5 sits behind PBUF inside the UT region");
static_assert(32768ull * 5632 * 2 == 32768ull * 4096 * 2 + 1536ull * 32768 * 2, "ACT alias");

typedef __bf16 bf16x2_t __attribute__((ext_vector_type(2)));
__device__ __forceinline__ unsigned pk2(float lo, float hi) { const f32x2 v = {lo, hi}; const bf16x2_t r = __builtin_convertvector(v, bf16x2_t); return __builtin_bit_cast(unsigned, r); }
__device__ __forceinline__ float bflo(unsigned w) { return __uint_as_float(w << 16); }
__device__ __forceinline__ float bfhi(unsigned w) { return __uint_as_float(w & 0xffff0000u); }
__device__ __forceinline__ float bf1(bf16_t w) { return __uint_as_float(((unsigned)w) << 16); }
__device__ __forceinline__ float fsigmoid(float x) { return __builtin_amdgcn_rcpf(1.0f + __builtin_amdgcn_exp2f(-1.44269504f * x)); }
__device__ __forceinline__ float gelu_tanh(float y) { const float z = 1.5957691216f * (y + 0.044715f * y * y * y); return y * fsigmoid(z); }
__device__ __forceinline__ float wave_sum(float v) {
#pragma unroll
    for (int o = 1; o < 64; o <<= 1) v += __shfl_xor(v, o);
    return v;
}
__device__ __forceinline__ u32x4 pack8(const f32x4 a, const f32x4 b) { u32x4 w; w.x = pk2(a[0], a[1]); w.y = pk2(a[2], a[3]); w.z = pk2(b[0], b[1]); w.w = pk2(b[2], b[3]); return w; }
__device__ __forceinline__ void st16_wt(void* p, u32x4 v) { asm volatile("global_store_dwordx4 %0, %1, off sc1\n\ts_nop 1" :: "v"(p), "v"(v) : "memory"); }
__device__ __forceinline__ void st16_wt_nt(void* p, u32x4 v) { asm volatile("global_store_dwordx4 %0, %1, off sc1 nt\n\ts_nop 1" :: "v"(p), "v"(v) : "memory"); }

#define XB_TMO      128
#define XB_XCNT(j)  (256  + 64 * (j))
#define XB_XSUB(j)  (1280 + 64 * (j))
#define XB_XGEN(j)  (2304 + 64 * (j))
#define XB_TOP      3328
#define XB_TOPGEN   3392
#define XCD_BAR_WORDS 3456
#define XB_SPIN_CAP (1u << 18)
__device__ __forceinline__ unsigned xb_ld(unsigned* p)              { return __hip_atomic_load(p, __ATOMIC_RELAXED, __HIP_MEMORY_SCOPE_AGENT); }
__device__ __forceinline__ unsigned xb_add(unsigned* p, unsigned v) { return __hip_atomic_fetch_add(p, v, __ATOMIC_RELAXED, __HIP_MEMORY_SCOPE_AGENT); }
__device__ __forceinline__ unsigned xb_xcc_id() { return (unsigned)__builtin_amdgcn_s_getreg((3 << 11) | 20) & 0xFu; }
#define XB_SPIN(cond, bar) do { unsigned _sp = 0; while (cond) { __builtin_amdgcn_s_sleep(1); \
    if ((++_sp & 255u) == 0u) { if (xb_ld(&(bar)[XB_TMO])) break; if (_sp > XB_SPIN_CAP) { atomicAdd(&(bar)[XB_TMO], 1u); break; } } } } while (0)
struct XcdBarrier { unsigned* bar; unsigned x; volatile LAS unsigned* st; };
__device__ __forceinline__ XcdBarrier xcd_barrier_post(unsigned* bar, volatile LAS unsigned* st) {
    XcdBarrier b; b.bar = bar; b.x = xb_xcc_id(); b.st = st;
    if (threadIdx.x == 0) (void)xb_add(&bar[XB_XCNT(b.x)], 1u);
    return b;
}
__device__ __forceinline__ void xcd_barrier_complete(unsigned* bar, unsigned x, unsigned& nloc, unsigned& nx) {
    const unsigned G = gridDim.x * gridDim.y * gridDim.z;
    unsigned sum, cnt, mine, sp = 0u;
    for (;;) {
        sum = 0u; cnt = 0u; mine = 0u;
#pragma unroll
        for (unsigned j = 0; j < 16; ++j) { const unsigned c = xb_ld(&bar[XB_XCNT(j)]); sum += c; cnt += (c > 0u) ? 1u : 0u; mine = (j == x) ? c : mine; }
        if (sum == G) break;
        __builtin_amdgcn_s_sleep(1);
        if ((++sp & 255u) == 0u) { if (xb_ld(&bar[XB_TMO])) break; if (sp > XB_SPIN_CAP) { atomicAdd(&bar[XB_TMO], 1u); break; } }
    }
    nloc = mine > 0u ? mine : 1u; nx = cnt > 0u ? cnt : 1u;
}
__device__ __forceinline__ void xcd_barrier(const XcdBarrier& b) {
    asm volatile("s_waitcnt vmcnt(0)" ::: "memory");
    __syncthreads();
    if (threadIdx.x == 0) {
        unsigned* bar = b.bar;
        __builtin_amdgcn_s_waitcnt(0);
        unsigned nloc = b.st[0], nx = b.st[1];
        if (nloc == 0u) { xcd_barrier_complete(bar, b.x, nloc, nx); b.st[0] = nloc; b.st[1] = nx; }
        const unsigned old = xb_add(&bar[XB_XSUB(b.x)], 1u);
        const unsigned gen = old / nloc;
        if (old + 1u == (gen + 1u) * nloc) {
            __builtin_amdgcn_fence(__ATOMIC_RELEASE, "agent");
            asm volatile("s_waitcnt vmcnt(0)" ::: "memory");
            const unsigned og = xb_add(&bar[XB_TOP], 1u);
            const unsigned tg = og / nx;
            if (og + 1u == (tg + 1u) * nx) xb_add(&bar[XB_TOPGEN], 1u);
            else XB_SPIN(xb_ld(&bar[XB_TOPGEN]) == tg, bar);
            __builtin_amdgcn_fence(__ATOMIC_ACQUIRE, "agent");
            xb_add(&bar[XB_XGEN(b.x)], 1u);
            asm volatile("s_waitcnt vmcnt(0)" ::: "memory");
        } else {
            XB_SPIN(xb_ld(&bar[XB_XGEN(b.x)]) == gen, bar);
            __builtin_amdgcn_fence(__ATOMIC_ACQUIRE, "agent");
            asm volatile("s_waitcnt vmcnt(0)" ::: "memory");
        }
    }
    __syncthreads();
}

namespace pg8 {
constexpr int BM = 256, BK = 64, HALF = 128, HTB = HALF * BK * 2, NXCD = 8, WGM = 8;
__device__ __forceinline__ int lds_byte(int r, int c) { const int st = (r >> 4) * 2 + (c >> 5), rr = r & 15, cc = c & 31, ob = rr * 64 + cc * 2; return st * 1024 + (ob ^ (((ob >> 9) & 1) << 5)); }
__device__ __forceinline__ void stage_rc(int b, int& R, int& C) { const int st = b / 1024, sb = b % 1024, swz = sb ^ (((sb >> 9) & 1) << 5); R = (st >> 1) * 16 + swz / 64; C = (st & 1) * 32 + (swz % 64) / 2; }
__device__ __forceinline__ int perm32(int rho) { const int n = rho >> 4, i = rho & 15; return 8 * (i >> 2) + 4 * n + (i & 3); }

struct Unit { int pm, pn, z; };
struct Gemm { const bf16_t* A; const bf16_t* Bt; int lda, ldb, K; size_t batchA, batchB; int amask; };

struct Order {
    int nM, nN, per, total, G, c, bres, wgm;
    __device__ __forceinline__ void init(int M, int N, int Z, int G_, int c_) { nM = M / BM; nN = N / BM; per = nM * nN; total = per * Z; G = G_; c = c_; bres = 0; wgm = (nN == 8) ? 4 : WGM; }
    __device__ __forceinline__ bool next(int i, Unit& u) const {
        const long L = (long)i * G + c; if (L >= total) return false;
        if (bres) {
            const int xcd = c & 7, cl = c >> 3; u.z = 0; u.pm = 16 * xcd + (cl & 15); u.pn = 2 * i + (cl >> 4); return true; }
        u.z = (int)(L / per); int wgid = (int)(L % per); const int nwg = per;
        { const int q = nwg / NXCD, r = nwg % NXCD, xcd = wgid % NXCD, off = wgid / NXCD; wgid = (xcd < r ? xcd * (q + 1) : r * (q + 1) + (xcd - r) * q) + off; }
        const int nig = wgm * nN, gid = wgid / nig, fm = gid * wgm, gsz = (nM - fm) < wgm ? (nM - fm) : wgm;
        u.pm = fm + ((wgid % nig) % gsz); u.pn = (wgid % nig) / gsz; return true;
    }
};

template <class Epi>
__device__ __forceinline__ void gemm_phase(LAS unsigned char* lds, const Gemm g, const Order& S, const Epi& E) {
    const int tid = threadIdx.x, wid = __builtin_amdgcn_readfirstlane(tid >> 6), lane = tid & 63, wr = wid >> 2, wc = wid & 3, fr = lane & 15, fq = lane >> 4;
    const int K = g.K, nt = K / BK;
    unsigned voffA[2], voffB[2];
#pragma unroll
    for (int i = 0; i < 2; ++i) { int R, C; stage_rc(tid * 16 + i * 8192, R, C); const int Rb = Epi::PERM ? ((R & ~31) + perm32(R & 31)) : R;
        voffA[i] = (unsigned)(R * g.lda + C) * 2u; voffB[i] = (unsigned)(Rb * g.ldb + C) * 2u; }
    const size_t kstep = (size_t)(BK * 2);
    const size_t hstepA = (size_t)HALF * g.lda * 2, hstepB = (size_t)HALF * g.ldb * 2;
    const size_t tstepA = 2 * hstepA, tstepB = 2 * hstepB;
    const unsigned ldsw = (unsigned)wid * 1024u;
    const int aoff = lds_byte(wr * 64 + fr, fq * 8), boff = lds_byte(wc * 32 + fr, fq * 8);
#define PG8_SA(b, h) (((b) * 2 + (h)) * HTB)
#define PG8_SB(b, h) ((4 + (b) * 2 + (h)) * HTB)
#define PG8_STAGE(bufoff, gbase, voff) do { _Pragma("unroll") for (int _i = 0; _i < 2; ++_i) \
        __builtin_amdgcn_global_load_lds((const unsigned*)((const char*)(gbase) + (voff)[_i]), (LAS unsigned*)(lds + (bufoff) + ldsw + _i * 8192), 16, 0, 0); } while (0)
#define PG8_LDA(dst, b, h) do { _Pragma("unroll") for (int m = 0; m < 4; ++m) _Pragma("unroll") for (int k = 0; k < 2; ++k) dst[m][k] = *(const LAS bf16x8*)(lds + PG8_SA(b, h) + aoff + m * 2048 + k * 1024); } while (0)
#define PG8_LDB(dst, b, h) do { _Pragma("unroll") for (int n = 0; n < 2; ++n) _Pragma("unroll") for (int k = 0; k < 2; ++k) dst[n][k] = *(const LAS bf16x8*)(lds + PG8_SB(b, h) + boff + n * 2048 + k * 1024); } while (0)
#define PG8_MMA(ai, bj, At, Bt) do { __builtin_amdgcn_s_setprio(1); _Pragma("unroll") for (int m = 0; m < 4; ++m) _Pragma("unroll") for (int n = 0; n < 2; ++n) _Pragma("unroll") for (int k = 0; k < 2; ++k) \
        acc[ai][bj][m][n] = __builtin_amdgcn_mfma_f32_16x16x32_bf16(Bt[n][k], At[m][k], acc[ai][bj][m][n], 0, 0, 0); __builtin_amdgcn_s_setprio(0); } while (0)
#define PG8_WAIT_V(n) asm volatile("s_waitcnt vmcnt(" #n ")" ::: "memory")
#define PG8_WAIT_L(n) asm volatile("s_waitcnt lgkmcnt(" #n ")" ::: "memory")
#define PG8_BAR __builtin_amdgcn_s_barrier()
#define PG8_SCHED __builtin_amdgcn_sched_barrier(0)
    Unit cur, nxt; int ui = 0;
    if (!S.next(0, cur)) return;
    f32x4 acc[2][2][4][2];
#pragma unroll
    for (int a = 0; a < 2; ++a)
#pragma unroll
        for (int b = 0; b < 2; ++b)
#pragma unroll
            for (int m = 0; m < 4; ++m)
#pragma unroll
                for (int n = 0; n < 2; ++n) acc[a][b][m][n] = (f32x4){0.f, 0.f, 0.f, 0.f};
    bf16x8 At[4][2], B0[2][2], B1[2][2];
    const char* cA = (const char*)g.A + (size_t)(cur.z & g.amask) * g.batchA + (size_t)cur.pm * tstepA;
    const char* cB = (const char*)g.Bt + (size_t)cur.z * g.batchB + (size_t)cur.pn * tstepB;
    PG8_STAGE(PG8_SB(0, 0), cB, voffB); PG8_STAGE(PG8_SB(0, 1), cB + hstepB, voffB); PG8_STAGE(PG8_SA(0, 0), cA, voffA); PG8_STAGE(PG8_SA(0, 1), cA + hstepA, voffA);
    if (wr == 1) PG8_BAR;
    PG8_WAIT_V(2); PG8_BAR;
    PG8_STAGE(PG8_SB(1, 0), cB + kstep, voffB); PG8_STAGE(PG8_SA(1, 0), cA + kstep, voffA); PG8_STAGE(PG8_SB(1, 1), cB + hstepB + kstep, voffB);
    PG8_WAIT_V(6); PG8_BAR;
    for (;;) {
        const bool has_next = S.next(ui + 1, nxt);
        const char* nA = has_next ? (const char*)g.A + (size_t)(nxt.z & g.amask) * g.batchA + (size_t)nxt.pm * tstepA : cA;
        const char* nB = has_next ? (const char*)g.Bt + (size_t)nxt.z * g.batchB + (size_t)nxt.pn * tstepB : cB;
        for (int t = 0; t < nt; t += 2) {
            const bool last = (t == nt - 2);
            const char* a1 = cA + (size_t)(t + 1) * kstep;
            const char* a2 = last ? nA : cA + (size_t)(t + 2) * kstep; const char* b2 = last ? nB : cB + (size_t)(t + 2) * kstep;
            const char* a3 = a2 + kstep; const char* b3 = b2 + kstep;
            PG8_LDB(B0, 0, 0); PG8_LDB(B1, 0, 1); PG8_SCHED; PG8_LDA(At, 0, 0); PG8_STAGE(PG8_SA(1, 1), a1 + hstepA, voffA);
            PG8_WAIT_V(8); PG8_WAIT_L(0); PG8_BAR; PG8_MMA(0, 0, At, B0); PG8_MMA(0, 1, At, B1); PG8_BAR; PG8_SCHED;
            PG8_LDA(At, 0, 1); PG8_STAGE(PG8_SB(0, 0), b2, voffB); PG8_STAGE(PG8_SB(0, 1), b2 + hstepB, voffB); PG8_STAGE(PG8_SA(0, 0), a2, voffA);
            PG8_WAIT_V(8); PG8_WAIT_L(0); PG8_BAR; PG8_MMA(1, 0, At, B0); PG8_MMA(1, 1, At, B1); PG8_BAR; PG8_SCHED;
            PG8_LDB(B0, 1, 0); PG8_LDB(B1, 1, 1); PG8_SCHED; PG8_LDA(At, 1, 0); PG8_STAGE(PG8_SA(0, 1), a2 + hstepA, voffA);
            PG8_WAIT_V(8); PG8_WAIT_L(0); PG8_BAR; PG8_MMA(0, 0, At, B0); PG8_MMA(0, 1, At, B1); PG8_BAR; PG8_SCHED;
            PG8_LDA(At, 1, 1); PG8_STAGE(PG8_SB(1, 0), b3, voffB); PG8_STAGE(PG8_SB(1, 1), b3 + hstepB, voffB); PG8_STAGE(PG8_SA(1, 0), a3, voffA);
            PG8_WAIT_V(8); PG8_WAIT_L(0); PG8_BAR; PG8_MMA(1, 0, At, B0); PG8_MMA(1, 1, At, B1); PG8_BAR; PG8_SCHED;
        }
        if (wr == 0) PG8_BAR;
        E(acc, cur, wr, wc, fr, fq);
        if (!has_next) break;
#pragma unroll
        for (int a = 0; a < 2; ++a)
#pragma unroll
            for (int b = 0; b < 2; ++b)
#pragma unroll
                for (int m = 0; m < 4; ++m)
#pragma unroll
                    for (int n = 0; n < 2; ++n) acc[a][b][m][n] = (f32x4){0.f, 0.f, 0.f, 0.f};
        cur = nxt; cA = nA; cB = nB; ++ui;
        if (wr == 1) PG8_BAR;
    }
    PG8_WAIT_V(0);
    PG8_BAR;
#undef PG8_SA
#undef PG8_SB
#undef PG8_STAGE
#undef PG8_LDA
#undef PG8_LDB
#undef PG8_MMA
#undef PG8_WAIT_V
#undef PG8_WAIT_L
#undef PG8_BAR
#undef PG8_SCHED
}
}
using pg8::Unit;
typedef f32x4 Acc[2][2][4][2];

#define EPI_ROWLOOP for (int ai = 0; ai < 2; ++ai) _Pragma("unroll") for (int m = 0; m < 4; ++m)
#define EPI_ROW (u.pm * 256 + ai * 128 + wr * 64 + m * 16 + fr)

struct EpiInProj {
    static constexpr bool PERM = true;
    bf16_t* A5; bf16_t* GATES;
    __device__ __forceinline__ void operator()(const Acc& acc, const Unit& u, int wr, int wc, int fr, int fq) const {
        const int cw = wc * 32 + 8 * fq;
        if (u.pn < 2) {
#pragma unroll
            EPI_ROWLOOP { const int row = EPI_ROW;
#pragma unroll
                for (int bj = 0; bj < 2; ++bj) { const int col = u.pn * 256 + bj * 128 + cw; const int gq = col >> 4, h0 = col & 15;
                    bf16_t* dst = A5 + ((size_t)gq * 1024 + (row >> 5)) * 768 + (row & 31) * 16 + h0;
                    st16_wt(dst, pack8(acc[ai][bj][m][0], acc[ai][bj][m][1])); } }
        } else {
#pragma unroll
            EPI_ROWLOOP { const int row = EPI_ROW; bf16_t* rowp = GATES + (size_t)row * 4096 + (u.pn - 2) * 256 + cw;
#pragma unroll
                for (int bj = 0; bj < 2; ++bj) { f32x4 v0 = acc[ai][bj][m][0], v1 = acc[ai][bj][m][1];
#pragma unroll
                    for (int j = 0; j < 4; ++j) { v0[j] = fsigmoid(v0[j]); v1[j] = fsigmoid(v1[j]); }
                    st16_wt_nt(rowp + bj * 128, pack8(v0, v1)); } }
        }
    }
};
struct EpiBf16 {
    static constexpr bool PERM = true;
    bf16_t* O; int ldc;
    __device__ __forceinline__ void operator()(const Acc& acc, const Unit& u, int wr, int wc, int fr, int fq) const {
        const int cw = u.pn * 256 + wc * 32 + 8 * fq;
#pragma unroll
        EPI_ROWLOOP { bf16_t* rowp = O + (size_t)EPI_ROW * ldc + cw;
#pragma unroll
            for (int bj = 0; bj < 2; ++bj) st16_wt(rowp + bj * 128, pack8(acc[ai][bj][m][0], acc[ai][bj][m][1])); }
    }
};
struct EpiF32 {
    static constexpr bool PERM = false;
    float* C;
    __device__ __forceinline__ void operator()(const Acc& acc, const Unit& u, int wr, int wc, int fr, int fq) const {
        const int cw = u.pn * 256 + wc * 32 + 4 * fq;
#pragma unroll
        EPI_ROWLOOP { float* rowp = C + ((size_t)u.z * 1024 + EPI_ROW) * 256 + cw;
#pragma unroll
            for (int bj = 0; bj < 2; ++bj)
#pragma unroll
                for (int n = 0; n < 2; ++n) *(f32x4*)(rowp + bj * 128 + n * 16) = acc[ai][bj][m][n]; }
    }
};
struct EpiDFT {
    static constexpr bool PERM = true;
    bf16_t* V; const float* UNQ;
    __device__ __forceinline__ void operator()(const Acc& acc, const Unit& u, int wr, int wc, int fr, int fq) const {
        const float sc = 0.011048543456039806f;
        const int cw = wc * 32 + 8 * fq; const int b = u.z >> 2, part = u.z & 3;
        f32x4 nq[2][2];
#pragma unroll
        for (int bj = 0; bj < 2; ++bj) { const float* np = UNQ + (size_t)(part * 4 + b) * 1536 + u.pn * 256 + bj * 128 + cw; const float sg = (fr & 1) ? -1.f : 1.f;
            nq[bj][0] = *(const f32x4*)np * sg; nq[bj][1] = *(const f32x4*)(np + 4) * sg; }
#pragma unroll
        EPI_ROWLOOP { const int k = 2 * EPI_ROW + (part & 1);
            bf16_t* rowp = V + ((size_t)b * 4096 + k) * 3072 + (part >> 1) * 1536 + u.pn * 256 + cw;
#pragma unroll
            for (int bj = 0; bj < 2; ++bj) st16_wt(rowp + bj * 128, pack8((acc[ai][bj][m][0] + nq[bj][0]) * sc, (acc[ai][bj][m][1] + nq[bj][1]) * sc)); }
    }
};
struct EpiBf16Z {
    static constexpr bool PERM = true;
    bf16_t* O; int ldc;
    __device__ __forceinline__ void operator()(const Acc& acc, const Unit& u, int wr, int wc, int fr, int fq) const {
        const int cw = u.z * 256 + wc * 32 + 8 * fq;
#pragma unroll
        EPI_ROWLOOP { bf16_t* rowp = O + (size_t)EPI_ROW * ldc + cw;
#pragma unroll
            for (int bj = 0; bj < 2; ++bj) st16_wt(rowp + bj * 128, pack8(acc[ai][bj][m][0], acc[ai][bj][m][1])); }
    }
};
struct EpiMergePQ {
    static constexpr bool PERM = true;
    const bf16_t* PB; const bf16_t* G; bf16_t* MG;
    __device__ __forceinline__ void operator()(const Acc& acc, const Unit& u, int wr, int wc, int fr, int fq) const {
        const int cw = u.pn * 256 + wc * 32 + 8 * fq;
#pragma unroll
        for (int ai = 0; ai < 2; ++ai)
#pragma unroll
        for (int mh = 0; mh < 2; ++mh) {
            u32x4 pw[2][2], g1[2][2], g2[2][2];
#pragma unroll
            for (int mm = 0; mm < 2; ++mm) { const int m = 2 * mh + mm; const int r = EPI_ROW; const int b = r >> 12, k = r & 4095;
                const size_t t1 = (size_t)b * 8192 + k, t2 = (size_t)b * 8192 + ((8192 - k) & 8191);
#pragma unroll
                for (int bj = 0; bj < 2; ++bj) { const int col = cw + bj * 128;
                    pw[mm][bj] = *(const u32x4*)(PB + (size_t)r * 2048 + col); g1[mm][bj] = *(const u32x4*)(G + t1 * 4096 + col); g2[mm][bj] = *(const u32x4*)(G + t2 * 4096 + col); } }
            asm volatile("" ::: "memory");
#pragma unroll
            for (int mm = 0; mm < 2; ++mm) { const int m = 2 * mh + mm; const int r = EPI_ROW; const int b = r >> 12, k = r & 4095;
                const size_t t1 = (size_t)b * 8192 + k, t2 = (size_t)b * 8192 + ((8192 - k) & 8191);
#pragma unroll
                for (int bj = 0; bj < 2; ++bj) { const int col = cw + bj * 128; const u32x4 pq = pw[mm][bj], ga = g1[mm][bj], gb = g2[mm][bj];
                    const f32x4 p0 = {bflo(pq.x), bfhi(pq.x), bflo(pq.y), bfhi(pq.y)}, p1 = {bflo(pq.z), bfhi(pq.z), bflo(pq.w), bfhi(pq.w)};
                    const f32x4 a0 = {bflo(ga.x), bfhi(ga.x), bflo(ga.y), bfhi(ga.y)}, a1 = {bflo(ga.z), bfhi(ga.z), bflo(ga.w), bfhi(ga.w)};
                    const f32x4 c0 = {bflo(gb.x), bfhi(gb.x), bflo(gb.y), bfhi(gb.y)}, c1 = {bflo(gb.z), bfhi(gb.z), bflo(gb.w), bfhi(gb.w)};
                    const f32x4 q0 = acc[ai][bj][m][0], q1 = acc[ai][bj][m][1];
                    st16_wt(MG + t1 * 2048 + col, pack8(a0 * (p0 + q0) * 0.0625f, a1 * (p1 + q1) * 0.0625f));
                    if (k != 0) st16_wt(MG + t2 * 2048 + col, pack8(c0 * (p0 - q0) * 0.0625f, c1 * (p1 - q1) * 0.0625f)); } }
            asm volatile("" ::: "memory");
        }
    }
};
struct EpiS5Out {
    static constexpr bool PERM = true;
    bf16_t* Y5;
    __device__ __forceinline__ void operator()(const Acc& acc, const Unit& u, int wr, int wc, int fr, int fq) const {
        const int cw = u.pn * 256 + wc * 32 + 8 * fq;
#pragma unroll
        EPI_ROWLOOP { const int r = EPI_ROW; const int b = r >> 8, c = r & 255;
#pragma unroll
            for (int bj = 0; bj < 2; ++bj) { const int col = cw + bj * 128; const int t = col >> 4, h0 = col & 15;
                f32x4 v0 = acc[ai][bj][m][0], v1 = acc[ai][bj][m][1];
#pragma unroll
                for (int j = 0; j < 4; ++j) { v0[j] = gelu_tanh(v0[j]); v1[j] = gelu_tanh(v1[j]); }
                st16_wt(Y5 + (size_t)(b * 8192 + c * 32 + t) * 512 + u.z * 16 + h0, pack8(v0, v1)); } }
    }
};
template <int MODE> struct EpiGated {
    static constexpr bool PERM = true;
    bf16_t* O; int ldc;
    __device__ __forceinline__ void operator()(const Acc& acc, const Unit& u, int wr, int wc, int fr, int fq) const {
        const int cw = u.pn * 128 + wc * 32 + 8 * fq;
#pragma unroll
        EPI_ROWLOOP { bf16_t* rowp = O + (size_t)EPI_ROW * ldc + cw;
            f32x4 v0, v1;
#pragma unroll
            for (int j = 0; j < 4; ++j) {
                const float p0 = acc[ai][0][m][0][j], q0 = acc[ai][1][m][0][j], p1 = acc[ai][0][m][1][j], q1 = acc[ai][1][m][1][j];
                if (MODE == 0) { v0[j] = p0 * fsigmoid(q0); v1[j] = p1 * fsigmoid(q1); }
                else { v0[j] = p0 * fsigmoid(p0) * q0; v1[j] = p1 * fsigmoid(p1) * q1; } }
            st16_wt(rowp, pack8(v0, v1)); }
    }
};
template <bool ADD> struct EpiMerge {
    static constexpr bool PERM = true;
    const bf16_t* G; bf16_t* MG;
    __device__ __forceinline__ void operator()(const Acc& acc, const Unit& u, int wr, int wc, int fr, int fq) const {
        const int cw = u.pn * 256 + wc * 32 + 8 * fq;
#pragma unroll
        for (int ai = 0; ai < 2; ++ai) {
            u32x4 gw[4][2], ow[4][2];
#pragma unroll
            for (int m = 0; m < 4; ++m)
#pragma unroll
                for (int bj = 0; bj < 2; ++bj) { const int row = EPI_ROW; const int col = cw + bj * 128;
                    gw[m][bj] = *(const u32x4*)(G + (size_t)row * 4096 + col);
                    if (ADD) ow[m][bj] = *(const u32x4*)(MG + (size_t)row * 2048 + col); }
            asm volatile("" ::: "memory");
#pragma unroll
            for (int m = 0; m < 4; ++m)
#pragma unroll
                for (int bj = 0; bj < 2; ++bj) { const int row = EPI_ROW; const int col = cw + bj * 128; const u32x4 g4 = gw[m][bj];
                    f32x4 v0 = acc[ai][bj][m][0], v1 = acc[ai][bj][m][1];
                    v0[0] *= bflo(g4.x); v0[1] *= bfhi(g4.x); v0[2] *= bflo(g4.y); v0[3] *= bfhi(g4.y);
                    v1[0] *= bflo(g4.z); v1[1] *= bfhi(g4.z); v1[2] *= bflo(g4.w); v1[3] *= bfhi(g4.w);
                    if (ADD) { const u32x4 o4 = ow[m][bj];
                        v0[0] += bflo(o4.x); v0[1] += bfhi(o4.x); v0[2] += bflo(o4.y); v0[3] += bfhi(o4.y);
                        v1[0] += bflo(o4.z); v1[1] += bfhi(o4.z); v1[2] += bflo(o4.w); v1[3] += bfhi(o4.w); }
                    st16_wt(MG + (size_t)row * 2048 + col, pack8(v0, v1)); }
            asm volatile("" ::: "memory");
        }
    }
};
struct EpiResidB {
    static constexpr bool PERM = true;
    const bf16_t* X1B; bf16_t* X2B; const float* gate;
    __device__ __forceinline__ void operator()(const Acc& acc, const Unit& u, int wr, int wc, int fr, int fq) const {
        const int cw = u.pn * 256 + wc * 32 + 8 * fq; const int b = u.pm >> 5;
        f32x4 gv[2][2];
#pragma unroll
        for (int bj = 0; bj < 2; ++bj)
#pragma unroll
            for (int n = 0; n < 2; ++n) gv[bj][n] = *(const f32x4*)(gate + (size_t)b * 12288 + cw + bj * 128 + 4 * n);
#pragma unroll
        for (int ai = 0; ai < 2; ++ai) {
            u32x4 xw[4][2];
#pragma unroll
            for (int m = 0; m < 4; ++m)
#pragma unroll
                for (int bj = 0; bj < 2; ++bj) xw[m][bj] = *(const u32x4*)(X1B + (size_t)EPI_ROW * 2048 + cw + bj * 128);
            asm volatile("" ::: "memory");
#pragma unroll
            for (int m = 0; m < 4; ++m)
#pragma unroll
                for (int bj = 0; bj < 2; ++bj) { const u32x4 w = xw[m][bj];
                    f32x4 v0 = gv[bj][0] * acc[ai][bj][m][0], v1 = gv[bj][1] * acc[ai][bj][m][1];
                    v0[0] += bflo(w.x); v0[1] += bfhi(w.x); v0[2] += bflo(w.y); v0[3] += bfhi(w.y);
                    v1[0] += bflo(w.z); v1[1] += bfhi(w.z); v1[2] += bflo(w.w); v1[3] += bfhi(w.w);
                    st16_wt(X2B + (size_t)EPI_ROW * 2048 + cw + bj * 128, pack8(v0, v1)); }
            asm volatile("" ::: "memory");
        }
    }
};
struct EpiResidX {
    static constexpr bool PERM = true;
    const float* base; bf16_t* X1B; const float* gate; const float* gw; bf16_t* XS; float* SSQ;
    __device__ __forceinline__ void operator()(const Acc& acc, const Unit& u, int wr, int wc, int fr, int fq) const {
        const int cw = u.pn * 256 + wc * 32 + 8 * fq; const int b = u.pm >> 5;
        f32x4 gv[2][2], gx[2][2];
#pragma unroll
        for (int bj = 0; bj < 2; ++bj)
#pragma unroll
            for (int n = 0; n < 2; ++n) { gv[bj][n] = *(const f32x4*)(gate + (size_t)b * 12288 + cw + bj * 128 + 4 * n); gx[bj][n] = *(const f32x4*)(gw + (size_t)b * 2048 + cw + bj * 128 + 4 * n); }
#pragma unroll
        EPI_ROWLOOP { const int row = EPI_ROW; const size_t off = (size_t)row * 2048 + cw; float t = 0.f;
            f32x4 bs[2][2];
#pragma unroll
            for (int bj = 0; bj < 2; ++bj)
#pragma unroll
                for (int n = 0; n < 2; ++n) bs[bj][n] = *(const f32x4*)(base + off + bj * 128 + 4 * n);
            asm volatile("" ::: "memory");
#pragma unroll
            for (int bj = 0; bj < 2; ++bj) { const f32x4 x0 = bs[bj][0] + gv[bj][0] * acc[ai][bj][m][0], x1 = bs[bj][1] + gv[bj][1] * acc[ai][bj][m][1];
                t += (x0[0] * x0[0] + x0[1] * x0[1]) + (x0[2] * x0[2] + x0[3] * x0[3]) + (x1[0] * x1[0] + x1[1] * x1[1]) + (x1[2] * x1[2] + x1[3] * x1[3]);
                st16_wt(X1B + off + bj * 128, pack8(x0, x1));
                st16_wt(XS + off + bj * 128, pack8(x0 * gx[bj][0], x1 * gx[bj][1])); }
            t += __shfl_xor(t, 16); t += __shfl_xor(t, 32);
            if (fq == 0) SSQ[(size_t)row * 32 + u.pn * 4 + wc] = t;
            asm volatile("" ::: "memory"); }
    }
};
struct EpiSwiGLU {
    static constexpr bool PERM = true;
    bf16_t* O; const float* RSTD; const float* BIAS;
    __device__ __forceinline__ void operator()(const Acc& acc, const Unit& u, int wr, int wc, int fr, int fq) const {
        const int cw = u.pn * 128 + wc * 32 + 8 * fq; const int b = u.pm >> 5;
        f32x4 bia[2][2];
#pragma unroll
        for (int bj = 0; bj < 2; ++bj)
#pragma unroll
            for (int n = 0; n < 2; ++n) bia[bj][n] = *(const f32x4*)(BIAS + (size_t)b * 11264 + u.pn * 256 + bj * 128 + wc * 32 + 8 * fq + 4 * n);
        float rsv[2][4];
#pragma unroll
        EPI_ROWLOOP rsv[ai][m] = RSTD[EPI_ROW];
        asm volatile("" ::: "memory");
#pragma unroll
        EPI_ROWLOOP { const int row = EPI_ROW; const float rs = rsv[ai][m]; bf16_t* rowp = O + (size_t)row * DFF + cw;
            f32x4 v0, v1;
#pragma unroll
            for (int j = 0; j < 4; ++j) {
                const float p0 = rs * acc[ai][0][m][0][j] + bia[0][0][j], q0 = rs * acc[ai][1][m][0][j] + bia[1][0][j];
                const float p1 = rs * acc[ai][0][m][1][j] + bia[0][1][j], q1 = rs * acc[ai][1][m][1][j] + bia[1][1][j];
                v0[j] = p0 * fsigmoid(p0) * q0; v1[j] = p1 * fsigmoid(p1) * q1; }
            st16_wt_nt(rowp, pack8(v0, v1)); }
    }
};

struct Ctx {
    LAS unsigned char* lds; int tid, lane, wave, G, bid;
    const float *x, *c, *w_ada, *b_ada, *norm_mix, *w_in, *lam_re, *lam_im, *log_step, *b_re, *b_im, *c_re, *c_im, *s5_d, *w_glu, *w_bs5, *w_bfn, *w_out, *norm_ffn, *w_ffi, *w_ffo, *norm_final;
    float* out; unsigned char* ws;
};

__device__ __forceinline__ void p0_adaln(const Ctx& F) {
    LAS float* cact = (LAS float*)F.lds;
    LAS float* red = (LAS float*)(F.lds + 32768);
    float* mod = (float*)(F.ws + WS_MOD);
    for (int i = F.tid; i < 8192; i += NTHR) { const float v = F.c[i]; cact[i] = v / (1.0f + __expf(-v)); }
    __syncthreads();
    for (int chunk = F.bid; chunk < 256; chunk += F.G) {
        const int j0 = chunk * 48, q = F.tid % 12, rl = F.tid / 12;
        f32x4 a0 = {0.f, 0.f, 0.f, 0.f}, a1 = a0, a2 = a0, a3 = a0;
        if (rl < 42) {
#pragma unroll 7
            for (int k = rl; k < 2048; k += 42) { const f32x4 w = *(const f32x4*)(F.w_ada + (size_t)k * 12288 + j0 + 4 * q);
                a0 += cact[k] * w; a1 += cact[2048 + k] * w; a2 += cact[4096 + k] * w; a3 += cact[6144 + k] * w; }
            *(LAS f32x4*)(red + (rl * 4 + 0) * 48 + 4 * q) = a0; *(LAS f32x4*)(red + (rl * 4 + 1) * 48 + 4 * q) = a1;
            *(LAS f32x4*)(red + (rl * 4 + 2) * 48 + 4 * q) = a2; *(LAS f32x4*)(red + (rl * 4 + 3) * 48 + 4 * q) = a3;
        }
        __syncthreads();
        if (F.tid < 192) { const int b = F.tid / 48, j = F.tid % 48; float s = 0.f;
            for (int r = 0; r < 42; ++r) s += red[(r * 4 + b) * 48 + j];
            mod[b * 12288 + j0 + j] = s + F.b_ada[j0 + j]; }
        __syncthreads();
    }
}

__device__ __forceinline__ void p0_s5_item(const Ctx& F, int item) {
    LAS float* bbr = (LAS float*)F.lds; LAS float* bbi = bbr + 1024; LAS float* cre = bbi + 1024; LAS float* cim = cre + 1024; LAS float* pwr = cim + 1024; LAS float* pwi = pwr + 1024;
    const int d = item >> 6, g = (item >> 1) & 31, q = item & 1, dg = d * 32 + g;
    const float dt = expf(F.log_step[dg]);
#pragma unroll
    for (int i = 0; i < 2; ++i) { const int e = F.tid + NTHR * i;
        { const int n = e >> 4, hp = e & 15; const float lr = F.lam_re[dg * 64 + n], li = F.lam_im[dg * 64 + n];
          const float mag = expf(lr * dt); float s, c0; sincosf(li * dt, &s, &c0); const float lbr = mag * c0, lbi = mag * s, den = lr * lr + li * li, nr = lbr - 1.0f, ni = lbi;
          const float cr = (nr * lr + ni * li) / den, ci = (ni * lr - nr * li) / den;
          const float br = F.b_re[((size_t)dg * 64 + n) * 16 + hp], bi = F.b_im[((size_t)dg * 64 + n) * 16 + hp];
          bbr[e] = cr * br - ci * bi; bbi[e] = cr * bi + ci * br;
          const int tl = hp; const float tau = (float)(16 * q + tl); const float pm = expf(lr * dt * tau); float ps, pc; sincosf(li * dt * tau, &ps, &pc); pwr[e] = pm * pc; pwi[e] = pm * ps; }
        { cre[e] = F.c_re[(size_t)dg * 1024 + e]; cim[e] = F.c_im[(size_t)dg * 1024 + e]; }
    }
    __syncthreads();
    { float* ktab = (float*)(F.ws + WS_KTAB);
      const int hh = F.tid & 255, h = hh >> 4, hp = hh & 15, sub = F.tid >> 8; float acc[8];
#pragma unroll
      for (int i = 0; i < 8; ++i) acc[i] = 0.f;
      for (int n = 0; n < 64; ++n) { const float Cr = cre[h * 64 + n], Ci = cim[h * 64 + n], Br = bbr[n * 16 + hp], Bi = bbi[n * 16 + hp];
          const float cbr = Cr * Br - Ci * Bi, cbi = Cr * Bi + Ci * Br;
#pragma unroll
          for (int i = 0; i < 8; ++i) { const int tl = 2 * i + sub; acc[i] += pwr[n * 16 + tl] * cbr - pwi[n * 16 + tl] * cbi; } }
#pragma unroll
      for (int i = 0; i < 8; ++i) ktab[((size_t)dg * 64 + 16 * q + 2 * i + sub) * 256 + hh] = acc[i]; }
    { bf16_t* bst = (bf16_t*)(F.ws + WS_BST);
#pragma unroll
      for (int i = 0; i < 8; ++i) { const int ch = F.tid + NTHR * i; const int rowi = ch >> 5, cc = ch & 31, tl = cc >> 1, hhalf = cc & 1, n = rowi & 63, im = rowi >> 6;
          const int tau = 16 * q + tl, tp = d == 0 ? 31 - tau : tau; const float pr = pwr[n * 16 + tl], pi = pwi[n * 16 + tl]; float v[8];
#pragma unroll
          for (int j = 0; j < 8; ++j) { const float Br = bbr[n * 16 + 8 * hhalf + j], Bi = bbi[n * 16 + 8 * hhalf + j]; v[j] = im ? (pr * Bi + pi * Br) : (pr * Br - pi * Bi); }
          u32x4 w; w.x = pk2(v[0], v[1]); w.y = pk2(v[2], v[3]); w.z = pk2(v[4], v[5]); w.w = pk2(v[6], v[7]);
          *(u32x4*)(bst + ((size_t)g * 256 + d * 128 + im * 64 + n) * 512 + tp * 16 + 8 * hhalf) = w; } }
    __syncthreads();
}

__device__ __forceinline__ void p0_transpose_item(const float* W, int K, int N, bf16_t* WT, int k0, int n0, int drow0, LAS float* scr, int lane) {
#pragma unroll 8
    for (int i = 0; i < 32; ++i) { const int kk = 2 * i + (lane >> 5); scr[kk * 33 + (lane & 31)] = W[(size_t)(k0 + kk) * N + n0 + (lane & 31)]; }
    asm volatile("s_waitcnt lgkmcnt(0)" ::: "memory");
    const int c = lane & 7;
#pragma unroll
    for (int j = 0; j < 4; ++j) { const int n = (lane >> 3) + 8 * j; const LAS float* s = scr + (8 * c) * 33 + n;
        u32x4 o; o.x = pk2(s[0 * 33], s[1 * 33]); o.y = pk2(s[2 * 33], s[3 * 33]); o.z = pk2(s[4 * 33], s[5 * 33]); o.w = pk2(s[6 * 33], s[7 * 33]);
        *(u32x4*)(WT + (size_t)(drow0 + n) * K + k0 + 8 * c) = o; }
    asm volatile("s_waitcnt lgkmcnt(0)" ::: "memory");
}
__device__ __forceinline__ void p0_weights(const Ctx& F) {
    LAS float* scr = (LAS float*)(F.lds + F.wave * 8448);
    const int gw = F.bid * 8 + F.wave, NGW = F.G * 8;
    constexpr int I_IN = 32 * 192, I_GLU = 8 * 32, I_BS5 = 8 * 64, I_BFN = 24 * 64, I_OUT = 32 * 64, I_FFI = 32 * 352, I_FFO = 88 * 64;
    constexpr int NITEMS = I_IN + I_GLU + I_BS5 + I_BFN + I_OUT + I_FFI + I_FFO;
    for (int it = gw; it < NITEMS; it += NGW) {
        int r = it;
        if (r < I_IN) { const int nb = r % 192, kb = r / 192, n0 = nb * 32; const int dr = n0 < 512 ? n0 : (n0 < 2048 ? n0 + 4096 : n0 - 1536);
            p0_transpose_item(F.w_in, 2048, 6144, (bf16_t*)(F.ws + WS_WIN), kb * 64, n0, dr, scr, F.lane); continue; } r -= I_IN;
        if (r < I_GLU) { const int nb = r % 32, kb = r / 32, n0 = nb * 32; const int j = n0 % 512, half = n0 / 512; const int dr = (j / 128) * 256 + half * 128 + (j % 128);
            p0_transpose_item(F.w_glu, 512, 1024, (bf16_t*)(F.ws + WS_WGLU), kb * 64, n0, dr, scr, F.lane); continue; } r -= I_GLU;
        if (r < I_BS5) { const int nb = r % 64, kb = r / 64; p0_transpose_item(F.w_bs5, 512, 2048, (bf16_t*)(F.ws + WS_WBS5), kb * 64, nb * 32, nb * 32, scr, F.lane); continue; } r -= I_BS5;
        if (r < I_BFN) { const int nb = r % 64, kb = r / 64; p0_transpose_item(F.w_bfn, 1536, 2048, (bf16_t*)(F.ws + WS_WBFN), kb * 64, nb * 32, nb * 32, scr, F.lane); continue; } r -= I_BFN;
        if (r < I_OUT) { const int nb = r % 64, kb = r / 64; p0_transpose_item(F.w_out, 2048, 2048, (bf16_t*)(F.ws + WS_WOUT), kb * 64, nb * 32, nb * 32, scr, F.lane); continue; } r -= I_OUT;
        if (r < I_FFI) { const int nb = r % 352, kb = r / 352, n0 = nb * 32; const int j = n0 % 5632, half = n0 / 5632; const int dr = (j / 128) * 256 + half * 128 + (j % 128);
            p0_transpose_item(F.w_ffi, 2048, 11264, (bf16_t*)(F.ws + WS_WFFI), kb * 64, n0, dr, scr, F.lane); continue; } r -= I_FFI;
        { const int nb = r % 64, kb = r / 64; p0_transpose_item(F.w_ffo, 5632, 2048, (bf16_t*)(F.ws + WS_WFFO), kb * 64, nb * 32, nb * 32, scr, F.lane); }
    }
}

__device__ __forceinline__ void p0_dft(const Ctx& F) {
    LAS float* tab = (LAS float*)F.lds;
    for (int i = F.tid; i < 8192; i += NTHR) tab[i] = cospif((float)i * (1.0f / 4096.0f));
    __syncthreads();
    bf16_t* dftm = (bf16_t*)(F.ws + WS_DFTM);
    const size_t nchunk = 8192ull * 256;
    for (size_t ch = (size_t)F.bid * NTHR + F.tid; ch < nchunk; ch += (size_t)F.G * NTHR) {
        const int r = (int)(ch >> 8), n0 = (int)(ch & 255) * 8; float v[8];
        const int part = r >> 11, j = r & 2047; const int k = 2 * j + (part & 1); const int sh = part >= 2 ? 2048 : 0;
#pragma unroll
        for (int q = 0; q < 8; ++q) v[q] = tab[(k * (n0 + q) + sh) & 8191];
        u32x4 w; w.x = pk2(v[0], v[1]); w.y = pk2(v[2], v[3]); w.z = pk2(v[4], v[5]); w.w = pk2(v[6], v[7]);
        *(u32x4*)(dftm + (size_t)r * 2048 + n0) = w;
    }
    bf16_t* cdm = (bf16_t*)(F.ws + WS_CDM);
    for (int ch = F.bid * NTHR + F.tid; ch < 512 * 64; ch += F.G * NTHR) {
        const int r = ch >> 6, c0 = (ch & 63) * 8; const int j = r & 255, neg = r >> 8; float v[8];
#pragma unroll
        for (int jj = 0; jj < 8; ++jj) { const int cc = c0 + jj; const int c = cc & 255; const int idx = ((j * c) & 255) * 32;
            v[jj] = cc < 256 ? tab[idx] : tab[(idx + (neg ? 2048 : 6144)) & 8191]; }
        u32x4 w; w.x = pk2(v[0], v[1]); w.y = pk2(v[2], v[3]); w.z = pk2(v[4], v[5]); w.w = pk2(v[6], v[7]);
        *(u32x4*)(cdm + (size_t)r * 512 + c0) = w;
    }
    __syncthreads();
}

__device__ __forceinline__ void p1_toep_item(const Ctx& F, int item) {
    const int g = item >> 5, t = item & 31;
    const float* ktab = (const float*)(F.ws + WS_KTAB); bf16_t* toep = (bf16_t*)(F.ws + WS_TOEP);
#pragma unroll
    for (int i = 0; i < 2; ++i) { const int ch = F.tid + NTHR * i; const int h = ch >> 6, kc = ch & 63, tp = kc >> 1, hh = kc & 1; f32x4 a, b;
        if (tp < t) { const float* s = ktab + ((size_t)(0 * 32 + g) * 64 + (t - tp)) * 256 + h * 16 + 8 * hh; a = *(const f32x4*)s; b = *(const f32x4*)(s + 4); }
        else if (tp > t) { const float* s = ktab + ((size_t)(1 * 32 + g) * 64 + (tp - t)) * 256 + h * 16 + 8 * hh; a = *(const f32x4*)s; b = *(const f32x4*)(s + 4); }
        else { const float* s0 = ktab + ((size_t)(0 * 32 + g) * 64) * 256 + h * 16 + 8 * hh; const float* s1 = ktab + ((size_t)(1 * 32 + g) * 64) * 256 + h * 16 + 8 * hh;
            a = *(const f32x4*)s0 + *(const f32x4*)s1; b = *(const f32x4*)(s0 + 4) + *(const f32x4*)(s1 + 4);
            const float dsk = F.s5_d[g * 16 + h]; const int hl = h - 8 * hh;
            if (hl >= 0 && hl < 4) a[hl] += dsk; else if (hl >= 4 && hl < 8) b[hl - 4] += dsk; }
        *(u32x4*)(toep + ((size_t)g * 512 + t * 16 + h) * 768 + tp * 16 + 8 * hh) = pack8(a, b); }
    if (F.tid < 256) { const int e = F.tid, d = e >> 7, h = (e >> 3) & 15, nc = e & 7, dg = d * 32 + g;
        const float dt = expf(F.log_step[dg]); const float p = d == 0 ? (float)(t + 1) : (float)(32 - t); f32x4 re0, re1, im0, im1;
#pragma unroll
        for (int j = 0; j < 8; ++j) { const int n = 8 * nc + j; const float lr = F.lam_re[dg * 64 + n], li = F.lam_im[dg * 64 + n];
            const float pm = expf(lr * dt * p); float ps, pc; sincosf(li * dt * p, &ps, &pc); const float pr = pm * pc, pi = pm * ps;
            const float Cr = F.c_re[((size_t)dg * 16 + h) * 64 + n], Ci = F.c_im[((size_t)dg * 16 + h) * 64 + n];
            const float re = Cr * pr - Ci * pi, imn = -(Cr * pi + Ci * pr);
            if (j < 4) { re0[j] = re; im0[j] = imn; } else { re1[j - 4] = re; im1[j - 4] = imn; } }
        bf16_t* dst = toep + ((size_t)g * 512 + t * 16 + h) * 768 + 512 + d * 128 + 8 * nc;
        *(u32x4*)dst = pack8(re0, re1); *(u32x4*)(dst + 64) = pack8(im0, im1); }
}

__device__ __forceinline__ void p1_ffn_mod(const Ctx& F) {
    const float* mod = (const float*)(F.ws + WS_MOD); float* gwp = (float*)(F.ws + WS_GW); float* bias = (float*)(F.ws + WS_BIAS);
    const bf16_t* wffi = (const bf16_t*)(F.ws + WS_WFFI);
    for (int i = F.bid * NTHR + F.tid; i < 8192; i += F.G * NTHR) gwp[i] = F.norm_ffn[i & 2047] * (1.0f + mod[(size_t)(i >> 11) * 12288 + 8192 + (i & 2047)]);
    const int gw = F.bid * 8 + F.wave, NGW = F.G * 8;
    for (int r = gw; r < 11264; r += NGW) { float s0 = 0.f, s1 = 0.f, s2 = 0.f, s3 = 0.f;
#pragma unroll
        for (int i = 0; i < 4; ++i) { const int k0 = (F.lane + 64 * i) * 8; const u32x4 w = *(const u32x4*)(wffi + (size_t)r * 2048 + k0);
            const float wv[8] = {bflo(w.x), bfhi(w.x), bflo(w.y), bfhi(w.y), bflo(w.z), bfhi(w.z), bflo(w.w), bfhi(w.w)};
#pragma unroll
            for (int b = 0; b < 4; ++b) { const float* sh = mod + (size_t)b * 12288 + 6144 + k0; const f32x4 a = *(const f32x4*)sh, c = *(const f32x4*)(sh + 4);
                const float t = (wv[0] * a[0] + wv[1] * a[1]) + (wv[2] * a[2] + wv[3] * a[3]) + (wv[4] * c[0] + wv[5] * c[1]) + (wv[6] * c[2] + wv[7] * c[3]);
                if (b == 0) s0 += t; else if (b == 1) s1 += t; else if (b == 2) s2 += t; else s3 += t; } }
        s0 = wave_sum(s0); s1 = wave_sum(s1); s2 = wave_sum(s2); s3 = wave_sum(s3);
        if (F.lane == 0) { bias[r] = s0; bias[11264 + r] = s1; bias[2 * 11264 + r] = s2; bias[3 * 11264 + r] = s3; } }
}
__device__ __forceinline__ void p10_rstd(const Ctx& F) {
    const float* ssq = (const float*)(F.ws + WS_SSQ); float* rstd = (float*)(F.ws + WS_RSTD);
    for (int row = F.bid * NTHR + F.tid; row < MTOK; row += F.G * NTHR) { const f32x4* p = (const f32x4*)(ssq + (size_t)row * 32); float t = 0.f;
#pragma unroll
        for (int i = 0; i < 8; ++i) { const f32x4 v = p[i]; t += (v[0] + v[1]) + (v[2] + v[3]); }
        rstd[row] = rsqrtf(t * (1.0f / 2048.0f) + 1e-6f); }
}
template <bool FINAL, int RB>
__device__ __forceinline__ void norm_rows(const Ctx& F, const float* src, const float* gamma, const float* shift, const float* scale, bf16_t* dstb, float* dstf) {
    const int gw = F.bid * 8 + F.wave, NGW = F.G * 8;
    for (int r0 = gw * 16; r0 < MTOK; r0 += NGW * 16) {
        const int b = r0 >> 13;
        f32x4 mul[8], add[8];
#pragma unroll
        for (int j = 0; j < 8; ++j) { const int col = 4 * F.lane + 256 * j; mul[j] = *(const f32x4*)(gamma + col);
            if (!FINAL) { mul[j] = mul[j] * (*(const f32x4*)(scale + (size_t)b * 12288 + col) + 1.0f); add[j] = *(const f32x4*)(shift + (size_t)b * 12288 + col); } }
        for (int r = r0; r < r0 + 16; r += RB) {
            f32x4 v[RB][8]; float s[RB];
#pragma unroll
            for (int q = 0; q < RB; ++q) { const f32x4* xr = (const f32x4*)(src + (size_t)(r + q) * 2048) + F.lane;
#pragma unroll
                for (int j = 0; j < 8; ++j) v[q][j] = xr[64 * j]; }
            asm volatile("" ::: "memory");
#pragma unroll
            for (int q = 0; q < RB; ++q) { float t = 0.f;
#pragma unroll
                for (int j = 0; j < 8; ++j) t += (v[q][j][0] * v[q][j][0] + v[q][j][1] * v[q][j][1]) + (v[q][j][2] * v[q][j][2] + v[q][j][3] * v[q][j][3]);
                s[q] = rsqrtf(wave_sum(t) * (1.0f / 2048.0f) + 1e-6f); }
#pragma unroll
            for (int q = 0; q < RB; ++q) {
                if (FINAL) { f32x4* orow = (f32x4*)(dstf + (size_t)(r + q) * 2048) + F.lane;
#pragma unroll
                    for (int j = 0; j < 8; ++j) orow[64 * j] = v[q][j] * s[q] * mul[j];
                } else { u32x2* orow = (u32x2*)(dstb + (size_t)(r + q) * 2048) + F.lane;
#pragma unroll
                    for (int j = 0; j < 8; ++j) { const f32x4 o = v[q][j] * s[q] * mul[j] + add[j]; u32x2 w; w.x = pk2(o[0], o[1]); w.y = pk2(o[2], o[3]); orow[64 * j] = w; } } }
            asm volatile("" ::: "memory");
        }
    }
}

__device__ __forceinline__ void final_norm(const Ctx& F, const bf16_t* src, const float* gamma, float* dst) {
    const int gw = F.bid * 8 + F.wave, NGW = F.G * 8;
    f32x4 mul[4][2];
#pragma unroll
    for (int j = 0; j < 4; ++j) { const int col = (F.lane + 64 * j) * 8; mul[j][0] = *(const f32x4*)(gamma + col); mul[j][1] = *(const f32x4*)(gamma + col + 4); }
    for (int r0 = gw * 16; r0 < MTOK; r0 += NGW * 16) {
        for (int r = r0; r < r0 + 16; r += 2) {
            u32x4 w[2][4]; float s[2];
#pragma unroll
            for (int q = 0; q < 2; ++q)
#pragma unroll
                for (int j = 0; j < 4; ++j) w[q][j] = *(const u32x4*)(src + (size_t)(r + q) * 2048 + (F.lane + 64 * j) * 8);
            asm volatile("" ::: "memory");
#pragma unroll
            for (int q = 0; q < 2; ++q) { float t = 0.f;
#pragma unroll
                for (int j = 0; j < 4; ++j) { const u32x4 x = w[q][j]; const float a0 = bflo(x.x), a1 = bfhi(x.x), a2 = bflo(x.y), a3 = bfhi(x.y), a4 = bflo(x.z), a5 = bfhi(x.z), a6 = bflo(x.w), a7 = bfhi(x.w);
                    t += (a0 * a0 + a1 * a1) + (a2 * a2 + a3 * a3) + (a4 * a4 + a5 * a5) + (a6 * a6 + a7 * a7); }
                s[q] = rsqrtf(wave_sum(t) * (1.0f / 2048.0f) + 1e-6f); }
#pragma unroll
            for (int q = 0; q < 2; ++q)
#pragma unroll
                for (int j = 0; j < 4; ++j) { const u32x4 x = w[q][j]; float* o = dst + (size_t)(r + q) * 2048 + (F.lane + 64 * j) * 8;
                    const f32x4 lo = {bflo(x.x), bfhi(x.x), bflo(x.y), bfhi(x.y)}, hi = {bflo(x.z), bfhi(x.z), bflo(x.w), bfhi(x.w)};
                    *(f32x4*)o = lo * s[q] * mul[j][0]; *(f32x4*)(o + 4) = hi * s[q] * mul[j][1]; }
            asm volatile("" ::: "memory");
        }
    }
}
__device__ __forceinline__ void p3_fold(const Ctx& F) {
    LAS unsigned char* img = F.lds + F.wave * 16384;
    const int gw = F.bid * 8 + F.wave, NGW = F.G * 8;
    bf16_t* UT = (bf16_t*)(F.ws + WS_UT); float* vnyq = (float*)(F.ws + WS_VNYQ); float* unq = (float*)(F.ws + WS_UNQ);
    for (int row = gw; row < 6144; row += NGW) {
        const int ch = row >> 2, b = row & 3;
        bf16_t* rp = UT + (size_t)ch * 32768 + b * 8192;
        float alt = 0.f;
#pragma unroll
        for (int i = 0; i < 16; ++i) { const u32x4 w = *(const u32x4*)(rp + (size_t)(F.lane + 64 * i) * 8);
            *(LAS u32x4*)(img + (F.lane + 64 * i) * 16) = w;
            alt += (bflo(w.x) - bfhi(w.x)) + (bflo(w.y) - bfhi(w.y)) + (bflo(w.z) - bfhi(w.z)) + (bflo(w.w) - bfhi(w.w)); }
        alt = wave_sum(alt);
        asm volatile("s_waitcnt vmcnt(0) lgkmcnt(0)" ::: "memory");
        if (F.lane == 0) { const float u2048 = bf1(*(const LAS bf16_t*)(img + 2048 * 2)), u6144 = bf1(*(const LAS bf16_t*)(img + 6144 * 2));
            vnyq[b * 1536 + ch] = alt * 0.011048543456039806f;
            unq[(0 * 4 + b) * 1536 + ch] = u2048 + u6144; unq[(1 * 4 + b) * 1536 + ch] = 0.f; unq[(2 * 4 + b) * 1536 + ch] = 0.f; unq[(3 * 4 + b) * 1536 + ch] = -(u2048 - u6144); }
        const float u4096 = bf1(*(const LAS bf16_t*)(img + 4096 * 2));
#pragma unroll
        for (int i = 0; i < 4; ++i) { const int j = F.lane + 64 * i;
            const u32x4 wa = *(const LAS u32x4*)(img + j * 16), wq = *(const LAS u32x4*)(img + 8192 + j * 16);
            const float a[8] = {bflo(wa.x), bfhi(wa.x), bflo(wa.y), bfhi(wa.y), bflo(wa.z), bfhi(wa.z), bflo(wa.w), bfhi(wa.w)};
            const float qv[8] = {bflo(wq.x), bfhi(wq.x), bflo(wq.y), bfhi(wq.y), bflo(wq.z), bfhi(wq.z), bflo(wq.w), bfhi(wq.w)};
            float ee[8], eo[8], oe[8], oo[8];
#pragma unroll
            for (int t = 0; t < 8; ++t) { const int n = 8 * j + t;
                const float c = bf1(*(const LAS bf16_t*)(img + ((8192 - n) & 8191) * 2)), pv = bf1(*(const LAS bf16_t*)(img + (4096 - n) * 2));
                if (n == 0) { ee[t] = a[t] + u4096; eo[t] = a[t] - u4096; oe[t] = 0.f; oo[t] = 0.f; }
                else { const float s1 = a[t] + c, d1 = a[t] - c, s2 = pv + qv[t], d2 = pv - qv[t]; ee[t] = s1 + s2; eo[t] = s1 - s2; oe[t] = d1 - d2; oo[t] = d1 + d2; } }
            u32x4 w0, w1, w2, w3;
            w0.x = pk2(ee[0], ee[1]); w0.y = pk2(ee[2], ee[3]); w0.z = pk2(ee[4], ee[5]); w0.w = pk2(ee[6], ee[7]);
            w1.x = pk2(eo[0], eo[1]); w1.y = pk2(eo[2], eo[3]); w1.z = pk2(eo[4], eo[5]); w1.w = pk2(eo[6], eo[7]);
            w2.x = pk2(oe[0], oe[1]); w2.y = pk2(oe[2], oe[3]); w2.z = pk2(oe[4], oe[5]); w2.w = pk2(oe[6], oe[7]);
            w3.x = pk2(oo[0], oo[1]); w3.y = pk2(oo[2], oo[3]); w3.z = pk2(oo[4], oo[5]); w3.w = pk2(oo[6], oo[7]);
            *(u32x4*)(rp + (size_t)j * 8) = w0; *(u32x4*)(rp + 2048 + (size_t)j * 8) = w1; *(u32x4*)(rp + 4096 + (size_t)j * 8) = w2; *(u32x4*)(rp + 6144 + (size_t)j * 8) = w3; }
        asm volatile("s_waitcnt lgkmcnt(0)" ::: "memory");
    }
}
__device__ __forceinline__ void p4_scan(const Ctx& F) {
    const int gt = F.bid * NTHR + F.tid; if (gt >= 16384) return;
    const int n = gt & 63, d = (gt >> 6) & 1, g = (gt >> 7) & 31, b = gt >> 12, dg = d * 32 + g;
    const float dt = expf(F.log_step[dg]); const float lr = F.lam_re[dg * 64 + n], li = F.lam_im[dg * 64 + n];
    const float pm = expf(lr * dt * 32.0f); float ps, pc; sincosf(li * dt * 32.0f, &ps, &pc); const float ar = pm * pc, ai = pm * ps;
    const float* sst = (const float*)(F.ws + WS_SST) + ((size_t)g * 1024 + b * 256) * 256 + d * 128 + n;
    bf16_t* a5 = (bf16_t*)(F.ws + WS_A5) + ((size_t)g * 1024 + b * 256) * 768 + 512 + d * 128 + n;
    float er = 0.f, ei = 0.f;
    for (int c0 = 0; c0 < 256; c0 += 32) { float sr[32], si[32];
#pragma unroll
        for (int j = 0; j < 32; ++j) { const int c = d == 0 ? (c0 + j) : (255 - c0 - j); sr[j] = sst[(size_t)c * 256]; si[j] = sst[(size_t)c * 256 + 64]; }
#pragma unroll
        for (int j = 0; j < 32; ++j) { const int c = d == 0 ? (c0 + j) : (255 - c0 - j);
            a5[(size_t)c * 768] = (bf16_t)(pk2(er, 0.f) & 0xffffu); a5[(size_t)c * 768 + 64] = (bf16_t)(pk2(ei, 0.f) & 0xffffu);
            const float nr = ar * er - ai * ei + sr[j], ni = ar * ei + ai * er + si[j]; er = nr; ei = ni; } }
}
__device__ __forceinline__ void p6_nyquist(const Ctx& F) {
    const int o = (F.bid - 32) * NTHR + F.tid; if (F.bid < 32 || o >= 8192) return;
    const int b = o >> 11, n = o & 2047;
    const float* vn = (const float*)(F.ws + WS_VNYQ) + b * 1536; const bf16_t* cwt = (const bf16_t*)(F.ws + WS_CSW) + (size_t)n * 1536; float s = 0.f;
    for (int c = 0; c < 1536; c += 8) { const u32x4 w = *(const u32x4*)(cwt + c); const f32x4 v0 = *(const f32x4*)(vn + c), v1 = *(const f32x4*)(vn + c + 4);
        s += (v0[0] * bflo(w.x) + v0[1] * bfhi(w.x)) + (v0[2] * bflo(w.y) + v0[3] * bfhi(w.y)) + (v1[0] * bflo(w.z) + v1[1] * bfhi(w.z)) + (v1[2] * bflo(w.w) + v1[3] * bfhi(w.w)); }
    const size_t tok = (size_t)b * 8192 + 4096;
    const float gt = bf1(((const bf16_t*)(F.ws + WS_GATES))[tok * 4096 + 2048 + n]);
    ((bf16_t*)(F.ws + WS_MG))[tok * 2048 + n] = (bf16_t)(pk2(gt * s * 0.0625f, 0.f) & 0xffffu);
}

struct Args { const float* in[22]; float* out; unsigned char* ws; int ph_lo, ph_hi; };

__global__ void __launch_bounds__(NTHR, 2) fwd_kernel(Args args) {
    extern __shared__ __attribute__((aligned(16))) unsigned char lds_raw[];
    cg::grid_group grid = cg::this_grid();
    Ctx F;
    F.lds = (LAS unsigned char*)lds_raw; F.tid = threadIdx.x; F.lane = F.tid & 63; F.wave = __builtin_amdgcn_readfirstlane(F.tid >> 6); F.G = gridDim.x; F.bid = blockIdx.x;
    F.x = args.in[0]; F.c = args.in[1]; F.w_ada = args.in[2]; F.b_ada = args.in[3]; F.norm_mix = args.in[4]; F.w_in = args.in[5];
    F.lam_re = args.in[6]; F.lam_im = args.in[7]; F.log_step = args.in[8]; F.b_re = args.in[9]; F.b_im = args.in[10]; F.c_re = args.in[11]; F.c_im = args.in[12];
    F.s5_d = args.in[13]; F.w_glu = args.in[14]; F.w_bs5 = args.in[15]; F.w_bfn = args.in[16]; F.w_out = args.in[17]; F.norm_ffn = args.in[18];
    F.w_ffi = args.in[19]; F.w_ffo = args.in[20]; F.norm_final = args.in[21]; F.out = args.out; F.ws = args.ws;
    unsigned char* ws = args.ws;
    const int lo = args.ph_lo, hi = args.ph_hi;
#define IN(k) (lo <= (k) && (k) < hi)
#define SEAM(k) do { if (IN(k) && IN((k) + 1)) xcd_barrier(xbar); } while (0)
    volatile LAS unsigned* xst = (volatile LAS unsigned*)(F.lds + LDS_STAGE);
    if (F.tid == 0) { xst[0] = 0u; xst[1] = 0u; }
    __syncthreads();
    XcdBarrier xbar; xbar.bar = (unsigned*)(ws + WS_BAR); xbar.x = 0; xbar.st = xst;
    if (hi - lo > 1) xbar = xcd_barrier_post((unsigned*)(ws + WS_BAR), xst);
    if (lo == 0x7fffffff) grid.sync();
    float* MOD = (float*)(ws + WS_MOD);
    bf16_t* H = (bf16_t*)(ws + WS_H); bf16_t* A5 = (bf16_t*)(ws + WS_A5); bf16_t* GATES = (bf16_t*)(ws + WS_GATES); bf16_t* UT = (bf16_t*)(ws + WS_UT);
    bf16_t* V = (bf16_t*)(ws + WS_V); bf16_t* YFN = (bf16_t*)(ws + WS_YFN); bf16_t* Y5 = (bf16_t*)(ws + WS_Y5); bf16_t* YS5 = (bf16_t*)(ws + WS_YS5);
    bf16_t* MG = (bf16_t*)(ws + WS_MG); bf16_t* ACT = (bf16_t*)(ws + WS_ACT);
    const bf16_t* WIN = (const bf16_t*)(ws + WS_WIN);

    if (IN(0)) {
        if (F.bid & 1) { p0_weights(F); __syncthreads(); }
        p0_adaln(F);
        for (int it = F.bid; it < 128; it += F.G) p0_s5_item(F, it);
        p0_dft(F);
        if (!(F.bid & 1)) p0_weights(F);
    }
    SEAM(0);
    if (IN(1)) {
        if (F.bid & 1) norm_rows<false, 2>(F, F.x, F.norm_mix, MOD + 0, MOD + 2048, H, nullptr);
        for (int it = F.bid; it < 1024; it += F.G) p1_toep_item(F, it);
        p1_ffn_mod(F);
        if (!(F.bid & 1)) norm_rows<false, 2>(F, F.x, F.norm_mix, MOD + 0, MOD + 2048, H, nullptr);
    }
    SEAM(1);
    if (IN(2)) {
        { pg8::Gemm g{H, WIN, 2048, 2048, 2048, 0, 0, 0xffff}; pg8::Order S; S.init(MTOK, 4608, 1, F.G, F.bid); EpiInProj E{A5, GATES}; pg8::gemm_phase(F.lds, g, S, E); }
        { pg8::Gemm g{WIN + (size_t)4608 * 2048, H, 2048, 2048, 2048, 0, 0, 0xffff}; pg8::Order S; S.init(1536, MTOK, 1, F.G, F.bid); EpiBf16 E{UT, MTOK}; pg8::gemm_phase(F.lds, g, S, E); }
    }
    SEAM(2);
    if (IN(3)) {
        { pg8::Gemm g{A5, (const bf16_t*)(ws + WS_BST), 768, 512, 512, 1024ull * 768 * 2, 256ull * 512 * 2, 0xffff}; pg8::Order S; S.init(1024, 256, 32, F.G, F.bid); EpiF32 E{(float*)(ws + WS_SST)}; pg8::gemm_phase(F.lds, g, S, E); }
        int kq = 256; asm volatile("" : "+s"(kq));
        { pg8::Gemm g{(const bf16_t*)(ws + WS_WBFN), (const bf16_t*)(ws + WS_CDM), 1536, 512, kq, 256ull * 2, 0, 0xffff}; pg8::Order S; S.init(2048, 256, 6, F.G, (F.bid + F.G - 128) % F.G);
          EpiBf16Z E{(bf16_t*)(ws + WS_CSW), 1536}; pg8::gemm_phase(F.lds, g, S, E); }
        { pg8::Gemm g{(const bf16_t*)(ws + WS_WBFN), (const bf16_t*)(ws + WS_CDM) + 256, 1536, 512, kq, 256ull * 2, 0, 0xffff}; pg8::Order S; S.init(2048, 256, 6, F.G, (F.bid + F.G - 128) % F.G);
          EpiBf16Z E{(bf16_t*)(ws + WS_CSW) + (size_t)2048 * 1536, 1536}; pg8::gemm_phase(F.lds, g, S, E); }
        p3_fold(F);
    }
    SEAM(3);
    if (IN(4)) {
        p4_scan(F);
        { pg8::Gemm g{(const bf16_t*)(ws + WS_DFTM), UT, 2048, MTOK, 2048, 2048ull * 2048 * 2, 2048ull * 2, 3}; pg8::Order S; S.init(2048, 1536, 16, F.G, F.bid); EpiDFT E{V, (const float*)(ws + WS_UNQ)}; pg8::gemm_phase(F.lds, g, S, E); }
    }
    SEAM(4);
    if (IN(5)) {
        { pg8::Gemm g{A5, (const bf16_t*)(ws + WS_TOEP), 768, 768, 768, 1024ull * 768 * 2, 512ull * 768 * 2, 0xffff}; pg8::Order S; S.init(1024, 512, 32, F.G, F.bid); EpiS5Out E{Y5}; pg8::gemm_phase(F.lds, g, S, E); }
        { pg8::Gemm g{V, (const bf16_t*)(ws + WS_CSW), 3072, 1536, 1536, 0, 0, 0xffff}; pg8::Order S; S.init(16384, 2048, 1, F.G, F.bid); EpiBf16 E{(bf16_t*)(ws + WS_PBUF), 2048}; pg8::gemm_phase(F.lds, g, S, E); }
    }
    SEAM(5);
    if (IN(6)) {
        { pg8::Gemm g{Y5, (const bf16_t*)(ws + WS_WGLU), 512, 512, 512, 0, 0, 0xffff}; pg8::Order S; S.init(MTOK, 1024, 1, F.G, F.bid); EpiGated<0> E{YS5, 512}; pg8::gemm_phase(F.lds, g, S, E); }
        p6_nyquist(F);
        { pg8::Gemm g{V + 1536, (const bf16_t*)(ws + WS_CSW) + (size_t)2048 * 1536, 3072, 1536, 1536, 0, 0, 0xffff}; pg8::Order S; S.init(16384, 2048, 1, F.G, F.bid); EpiMergePQ E{(const bf16_t*)(ws + WS_PBUF), GATES + 2048, MG}; pg8::gemm_phase(F.lds, g, S, E); }
    }
    SEAM(6);
    if (IN(7)) {
        { pg8::Gemm g{YS5, (const bf16_t*)(ws + WS_WBS5), 512, 512, 512, 0, 0, 0xffff}; pg8::Order S; S.init(MTOK, 2048, 1, F.G, F.bid); EpiMerge<true> E{GATES, MG}; pg8::gemm_phase(F.lds, g, S, E); }
    }
    SEAM(7);
    if (IN(9)) {
        pg8::Gemm g{MG, (const bf16_t*)(ws + WS_WOUT), 2048, 2048, 2048, 0, 0, 0xffff}; pg8::Order S; S.init(MTOK, 2048, 1, F.G, F.bid); EpiResidX E{F.x, (bf16_t*)F.out, MOD + 4096, (const float*)(ws + WS_GW), H, (float*)(ws + WS_SSQ)}; pg8::gemm_phase(F.lds, g, S, E);
    }
    SEAM(9);
    if (IN(10)) p10_rstd(F);
    SEAM(10);
    if (IN(11)) {
        pg8::Gemm g{H, (const bf16_t*)(ws + WS_WFFI), 2048, 2048, 2048, 0, 0, 0xffff}; pg8::Order S; S.init(MTOK, 11264, 1, F.G, F.bid); S.bres = (F.G == 256); EpiSwiGLU E{ACT, (const float*)(ws + WS_RSTD), (const float*)(ws + WS_BIAS)}; pg8::gemm_phase(F.lds, g, S, E);
    }
    SEAM(11);
    if (IN(12)) {
        pg8::Gemm g{ACT, (const bf16_t*)(ws + WS_WFFO), DFF, DFF, DFF, 0, 0, 0xffff}; pg8::Order S; S.init(MTOK, 2048, 1, F.G, F.bid); EpiResidB E{(const bf16_t*)F.out, MG, MOD + 10240}; pg8::gemm_phase(F.lds, g, S, E);
    }
    SEAM(12);
    if (IN(13)) final_norm(F, MG, F.norm_final, F.out);
#undef IN
#undef SEAM
}

extern "C" void kernel_launch(void* const* d_in, const int* in_sizes, int n_in, void* d_out, int out_size, void* d_ws, size_t ws_size, hipStream_t stream) {
    static int grid = 0;
    if (grid == 0) {
        int dev = 0, cus = 0, per_cu = 0;
        (void)hipGetDevice(&dev); (void)hipDeviceGetAttribute(&cus, hipDeviceAttributeMultiprocessorCount, dev);
        if (hipFuncSetAttribute((const void*)fwd_kernel, hipFuncAttributeMaxDynamicSharedMemorySize, LDS_BYTES) != hipSuccess) fprintf(stderr, "kernel_launch: hipFuncSetAttribute failed\n");
        if (hipOccupancyMaxActiveBlocksPerMultiprocessor(&per_cu, (const void*)fwd_kernel, NTHR, LDS_BYTES) != hipSuccess || per_cu < 1) per_cu = 1;
        (void)hipGetLastError();
        if (cus <= 0) cus = 256;
        grid = cus;
        if (ws_size < WS_END) fprintf(stderr, "kernel_launch: workspace too small: %zu < %zu\n", ws_size, (size_t)WS_END);
    }
    Args a{};
    for (int i = 0; i < 22; ++i) a.in[i] = (const float*)d_in[i];
    a.out = (float*)d_out; a.ws = (unsigned char*)d_ws;
#if ONE_LAUNCH
    (void)hipMemsetAsync((char*)d_ws + WS_BAR, 0, XCD_BAR_WORDS * 4, stream);
    a.ph_lo = 0; a.ph_hi = NPH;
    void* kargs[] = {&a};
    hipError_t e = hipLaunchCooperativeKernel((const void*)fwd_kernel, dim3(grid), dim3(NTHR), kargs, LDS_BYTES, stream);
    if (e != hipSuccess) fprintf(stderr, "cooperative launch failed: %s (grid %d)\n", hipGetErrorString(e), grid);
#else
    for (int ph = 0; ph < NPH; ++ph) { a.ph_lo = ph; a.ph_hi = ph + 1; hipLaunchKernelGGL(fwd_kernel, dim3(grid), dim3(NTHR), LDS_BYTES, stream, a); }
#endif
}
```

```cpp
#include <hip/hip_runtime.h>
#include <hip/hip_cooperative_groups.h>
#include <cstdio>
namespace cg = cooperative_groups;

#ifndef ONE_LAUNCH
#define ONE_LAUNCH 1
#endif

#define LAS __attribute__((address_space(3)))
typedef unsigned short bf16_t;
typedef short bf16x8 __attribute__((ext_vector_type(8)));
typedef float f32x4 __attribute__((ext_vector_type(4)));
typedef float f32x2 __attribute__((ext_vector_type(2)));
typedef unsigned u32x4 __attribute__((ext_vector_type(4)));
typedef unsigned u32x2 __attribute__((ext_vector_type(2)));

constexpr int NTHR = 512;
constexpr int MTOK = 32768, DM = 2048, SEQ = 8192, NB = 4;
constexpr int DFF = 5632;
constexpr int LDS_STAGE = 131072;
constexpr int LDS_BYTES = LDS_STAGE + 16;
constexpr int NPH = 14;

constexpr size_t al256(size_t x) { return (x + 255) & ~(size_t)255; }
constexpr size_t WS_BAR   = 0;
constexpr size_t WS_MOD   = 16384;
constexpr size_t WS_VNYQ  = al256(WS_MOD + 4ull * 12288 * 4);
constexpr size_t WS_UNQ   = al256(WS_VNYQ + 4ull * 1536 * 4);
constexpr size_t WS_GW    = al256(WS_UNQ + 16ull * 1536 * 4);
constexpr size_t WS_BIAS  = al256(WS_GW + 4ull * 2048 * 4);
constexpr size_t WS_RSTD  = al256(WS_BIAS + 4ull * 11264 * 4);
constexpr size_t WS_SSQ   = al256(WS_RSTD + 32768ull * 4);
constexpr size_t WS_WIN   = al256(WS_SSQ + 32768ull * 32 * 4);
constexpr size_t WS_WGLU  = WS_WIN + 6144ull * 2048 * 2;
constexpr size_t WS_WBS5  = WS_WGLU + 1024ull * 512 * 2;
constexpr size_t WS_WBFN  = WS_WBS5 + 2048ull * 512 * 2;
constexpr size_t WS_WOUT  = WS_WBFN + 2048ull * 1536 * 2;
constexpr size_t WS_WFFI  = WS_WOUT + 2048ull * 2048 * 2;
constexpr size_t WS_WFFO  = WS_WFFI + 11264ull * 2048 * 2;
constexpr size_t WS_DFTM  = WS_WFFO + 2048ull * 5632 * 2;
constexpr size_t WS_MG    = WS_DFTM;
constexpr size_t WS_CDM   = WS_DFTM + 8192ull * 8192 * 2;
constexpr size_t WS_KTAB  = WS_CDM + 512ull * 512 * 2;
constexpr size_t WS_TOEP  = WS_KTAB + 2ull * 32 * 64 * 256 * 4;
constexpr size_t WS_BST   = WS_TOEP + 32ull * 512 * 768 * 2;
constexpr size_t WS_H     = WS_BST + 32ull * 256 * 512 * 2;
constexpr size_t WS_A5    = WS_H + 32768ull * 2048 * 2;
constexpr size_t WS_SST   = WS_A5 + 32ull * 1024 * 768 * 2;
constexpr size_t WS_V     = WS_SST + 32ull * 1024 * 256 * 4;
constexpr size_t WS_Y5    = WS_H;
constexpr size_t WS_YS5   = WS_V + 16384ull * 3072 * 2 + 32768ull * 4096 * 2 + 16384ull * 2048 * 2;
constexpr size_t WS_GATES = WS_V + 16384ull * 3072 * 2;
constexpr size_t WS_UT    = WS_GATES + 32768ull * 4096 * 2;
constexpr size_t WS_YFN   = WS_UT;
constexpr size_t WS_ACT   = WS_GATES;
constexpr size_t WS_CSW   = WS_UT + 1536ull * 32768 * 2;
constexpr size_t WS_PBUF  = WS_UT;
constexpr size_t WS_END   = WS_CSW + 2ull * 2048 * 1536 * 2;
static_assert(WS_END <= (1ull << 30), "workspace map must fit 1 GiB");
static_assert(WS_YS5 == WS_UT + 16384ull * 2048 * 2 && WS_YS5 + 32768ull * 512 * 2 <= WS_CSW, "YS5 sits behind PBUF inside the UT region");
static_assert(32768ull * 5632 * 2 == 32768ull * 4096 * 2 + 1536ull * 32768 * 2, "ACT alias");

typedef __bf16 bf16x2_t __attribute__((ext_vector_type(2)));
__device__ __forceinline__ unsigned pk2(float lo, float hi) { const f32x2 v = {lo, hi}; const bf16x2_t r = __builtin_convertvector(v, bf16x2_t); return __builtin_bit_cast(unsigned, r); }
__device__ __forceinline__ float bflo(unsigned w) { return __uint_as_float(w << 16); }
__device__ __forceinline__ float bfhi(unsigned w) { return __uint_as_float(w & 0xffff0000u); }
__device__ __forceinline__ float bf1(bf16_t w) { return __uint_as_float(((unsigned)w) << 16); }
__device__ __forceinline__ float fsigmoid(float x) { return __builtin_amdgcn_rcpf(1.0f + __builtin_amdgcn_exp2f(-1.44269504f * x)); }
__device__ __forceinline__ float gelu_tanh(float y) { const float z = 1.5957691216f * (y + 0.044715f * y * y * y); return y * fsigmoid(z); }
__device__ __forceinline__ float wave_sum(float v) {
#pragma unroll
    for (int o = 1; o < 64; o <<= 1) v += __shfl_xor(v, o);
    return v;
}
__device__ __forceinline__ u32x4 pack8(const f32x4 a, const f32x4 b) { u32x4 w; w.x = pk2(a[0], a[1]); w.y = pk2(a[2], a[3]); w.z = pk2(b[0], b[1]); w.w = pk2(b[2], b[3]); return w; }

#define XB_TMO      128
#define XB_XCNT(j)  (256  + 64 * (j))
#define XB_XSUB(j)  (1280 + 64 * (j))
#define XB_XGEN(j)  (2304 + 64 * (j))
#define XB_TOP      3328
#define XB_TOPGEN   3392
#define XCD_BAR_WORDS 3456
#define XB_SPIN_CAP (1u << 18)
__device__ __forceinline__ unsigned xb_ld(unsigned* p)              { return __hip_atomic_load(p, __ATOMIC_RELAXED, __HIP_MEMORY_SCOPE_AGENT); }
__device__ __forceinline__ unsigned xb_add(unsigned* p, unsigned v) { return __hip_atomic_fetch_add(p, v, __ATOMIC_RELAXED, __HIP_MEMORY_SCOPE_AGENT); }
__device__ __forceinline__ unsigned xb_xcc_id() { return (unsigned)__builtin_amdgcn_s_getreg((3 << 11) | 20) & 0xFu; }
#define XB_SPIN(cond, bar) do { unsigned _sp = 0; while (cond) { __builtin_amdgcn_s_sleep(1); \
    if ((++_sp & 255u) == 0u) { if (xb_ld(&(bar)[XB_TMO])) break; if (_sp > XB_SPIN_CAP) { atomicAdd(&(bar)[XB_TMO], 1u); break; } } } } while (0)
struct XcdBarrier { unsigned* bar; unsigned x; volatile LAS unsigned* st; };
__device__ __forceinline__ XcdBarrier xcd_barrier_post(unsigned* bar, volatile LAS unsigned* st) {
    XcdBarrier b; b.bar = bar; b.x = xb_xcc_id(); b.st = st;
    if (threadIdx.x == 0) (void)xb_add(&bar[XB_XCNT(b.x)], 1u);
    return b;
}
__device__ __forceinline__ void xcd_barrier_complete(unsigned* bar, unsigned x, unsigned& nloc, unsigned& nx) {
    const unsigned G = gridDim.x * gridDim.y * gridDim.z;
    unsigned sum, cnt, mine, sp = 0u;
    for (;;) {
        sum = 0u; cnt = 0u; mine = 0u;
#pragma unroll
        for (unsigned j = 0; j < 16; ++j) { const unsigned c = xb_ld(&bar[XB_XCNT(j)]); sum += c; cnt += (c > 0u) ? 1u : 0u; mine = (j == x) ? c : mine; }
        if (sum == G) break;
        __builtin_amdgcn_s_sleep(1);
        if ((++sp & 255u) == 0u) { if (xb_ld(&bar[XB_TMO])) break; if (sp > XB_SPIN_CAP) { atomicAdd(&bar[XB_TMO], 1u); break; } }
    }
    nloc = mine > 0u ? mine : 1u; nx = cnt > 0u ? cnt : 1u;
}
__device__ __forceinline__ void xcd_barrier(const XcdBarrier& b) {
    asm volatile("s_waitcnt vmcnt(0)" ::: "memory");
    __syncthreads();
    if (threadIdx.x == 0) {
        unsigned* bar = b.bar;
        __builtin_amdgcn_s_waitcnt(0);
        unsigned nloc = b.st[0], nx = b.st[1];
        if (nloc == 0u) { xcd_barrier_complete(bar, b.x, nloc, nx); b.st[0] = nloc; b.st[1] = nx; }
        const unsigned old = xb_add(&bar[XB_XSUB(b.x)], 1u);
        const unsigned gen = old / nloc;
        if (old + 1u == (gen + 1u) * nloc) {
            __builtin_amdgcn_fence(__ATOMIC_RELEASE, "agent");
            asm volatile("s_waitcnt vmcnt(0)" ::: "memory");
            const unsigned og = xb_add(&bar[XB_TOP], 1u);
            const unsigned tg = og / nx;
            if (og + 1u == (tg + 1u) * nx) xb_add(&bar[XB_TOPGEN], 1u);
            else XB_SPIN(xb_ld(&bar[XB_TOPGEN]) == tg, bar);
            __builtin_amdgcn_fence(__ATOMIC_ACQUIRE, "agent");
            xb_add(&bar[XB_XGEN(b.x)], 1u);
            asm volatile("s_waitcnt vmcnt(0)" ::: "memory");
        } else {
            XB_SPIN(xb_ld(&bar[XB_XGEN(b.x)]) == gen, bar);
            __builtin_amdgcn_fence(__ATOMIC_ACQUIRE, "agent");
            asm volatile("s_waitcnt vmcnt(0)" ::: "memory");
        }
    }
    __syncthreads();
}

namespace pg8 {
constexpr int BM = 256, BK = 64, HALF = 128, HTB = HALF * BK * 2, NXCD = 8, WGM = 8;
__device__ __forceinline__ int lds_byte(int r, int c) { const int st = (r >> 4) * 2 + (c >> 5), rr = r & 15, cc = c & 31, ob = rr * 64 + cc * 2; return st * 1024 + (ob ^ (((ob >> 9) & 1) << 5)); }
__device__ __forceinline__ void stage_rc(int b, int& R, int& C) { const int st = b / 1024, sb = b % 1024, swz = sb ^ (((sb >> 9) & 1) << 5); R = (st >> 1) * 16 + swz / 64; C = (st & 1) * 32 + (swz % 64) / 2; }
__device__ __forceinline__ int perm32(int rho) { const int n = rho >> 4, i = rho & 15; return 8 * (i >> 2) + 4 * n + (i & 3); }

struct Unit { int pm, pn, z; };
struct Gemm { const bf16_t* A; const bf16_t* Bt; int lda, ldb, K; size_t batchA, batchB; int amask; };

struct Order {
    int nM, nN, per, total, G, c, bres, wgm;
    __device__ __forceinline__ void init(int M, int N, int Z, int G_, int c_) { nM = M / BM; nN = N / BM; per = nM * nN; total = per * Z; G = G_; c = c_; bres = 0; wgm = (nN == 8) ? 4 : WGM; }
    __device__ __forceinline__ bool next(int i, Unit& u) const {
        const long L = (long)i * G + c; if (L >= total) return false;
        if (bres) {
            const int xcd = c & 7, cl = c >> 3; u.z = 0; u.pm = 16 * xcd + (cl & 15); u.pn = 2 * i + (cl >> 4); return true; }
        u.z = (int)(L / per); int wgid = (int)(L % per); const int nwg = per;
        { const int q = nwg / NXCD, r = nwg % NXCD, xcd = wgid % NXCD, off = wgid / NXCD; wgid = (xcd < r ? xcd * (q + 1) : r * (q + 1) + (xcd - r) * q) + off; }
        const int nig = wgm * nN, gid = wgid / nig, fm = gid * wgm, gsz = (nM - fm) < wgm ? (nM - fm) : wgm;
        u.pm = fm + ((wgid % nig) % gsz); u.pn = (wgid % nig) / gsz; return true;
    }
};

template <class Epi>
__device__ __forceinline__ void gemm_phase(LAS unsigned char* lds, const Gemm g, const Order& S, const Epi& E) {
    const int tid = threadIdx.x, wid = __builtin_amdgcn_readfirstlane(tid >> 6), lane = tid & 63, wr = wid >> 2, wc = wid & 3, fr = lane & 15, fq = lane >> 4;
    const int K = g.K, nt = K / BK;
    unsigned voffA[2], voffB[2];
#pragma unroll
    for (int i = 0; i < 2; ++i) { int R, C; stage_rc(tid * 16 + i * 8192, R, C); const int Rb = Epi::PERM ? ((R & ~31) + perm32(R & 31)) : R;
        voffA[i] = (unsigned)(R * g.lda + C) * 2u; voffB[i] = (unsigned)(Rb * g.ldb + C) * 2u; }
    const size_t kstep = (size_t)(BK * 2);
    const size_t hstepA = (size_t)HALF * g.lda * 2, hstepB = (size_t)HALF * g.ldb * 2;
    const size_t tstepA = 2 * hstepA, tstepB = 2 * hstepB;
    const unsigned ldsw = (unsigned)wid * 1024u;
    const int aoff = lds_byte(wr * 64 + fr, fq * 8), boff = lds_byte(wc * 32 + fr, fq * 8);
#define PG8_SA(b, h) (((b) * 2 + (h)) * HTB)
#define PG8_SB(b, h) ((4 + (b) * 2 + (h)) * HTB)
#define PG8_STAGE(bufoff, gbase, voff) do { _Pragma("unroll") for (int _i = 0; _i < 2; ++_i) \
        __builtin_amdgcn_global_load_lds((const unsigned*)((const char*)(gbase) + (voff)[_i]), (LAS unsigned*)(lds + (bufoff) + ldsw + _i * 8192), 16, 0, 0); } while (0)
#define PG8_LDA(dst, b, h) do { _Pragma("unroll") for (int m = 0; m < 4; ++m) _Pragma("unroll") for (int k = 0; k < 2; ++k) dst[m][k] = *(const LAS bf16x8*)(lds + PG8_SA(b, h) + aoff + m * 2048 + k * 1024); } while (0)
#define PG8_LDB(dst, b, h) do { _Pragma("unroll") for (int n = 0; n < 2; ++n) _Pragma("unroll") for (int k = 0; k < 2; ++k) dst[n][k] = *(const LAS bf16x8*)(lds + PG8_SB(b, h) + boff + n * 2048 + k * 1024); } while (0)
#define PG8_MMA(ai, bj, At, Bt) do { __builtin_amdgcn_s_setprio(1); _Pragma("unroll") for (int m = 0; m < 4; ++m) _Pragma("unroll") for (int n = 0; n < 2; ++n) _Pragma("unroll") for (int k = 0; k < 2; ++k) \
        acc[ai][bj][m][n] = __builtin_amdgcn_mfma_f32_16x16x32_bf16(Bt[n][k], At[m][k], acc[ai][bj][m][n], 0, 0, 0); __builtin_amdgcn_s_setprio(0); } while (0)
#define PG8_WAIT_V(n) asm volatile("s_waitcnt vmcnt(" #n ")" ::: "memory")
#define PG8_WAIT_L(n) asm volatile("s_waitcnt lgkmcnt(" #n ")" ::: "memory")
#define PG8_BAR __builtin_amdgcn_s_barrier()
#define PG8_SCHED __builtin_amdgcn_sched_barrier(0)
    Unit cur, nxt; int ui = 0;
    if (!S.next(0, cur)) return;
    f32x4 acc[2][2][4][2];
#pragma unroll
    for (int a = 0; a < 2; ++a)
#pragma unroll
        for (int b = 0; b < 2; ++b)
#pragma unroll
            for (int m = 0; m < 4; ++m)
#pragma unroll
                for (int n = 0; n < 2; ++n) acc[a][b][m][n] = (f32x4){0.f, 0.f, 0.f, 0.f};
    bf16x8 At[4][2], B0[2][2], B1[2][2];
    const char* cA = (const char*)g.A + (size_t)(cur.z & g.amask) * g.batchA + (size_t)cur.pm * tstepA;
    const char* cB = (const char*)g.Bt + (size_t)cur.z * g.batchB + (size_t)cur.pn * tstepB;
    PG8_STAGE(PG8_SB(0, 0), cB, voffB); PG8_STAGE(PG8_SB(0, 1), cB + hstepB, voffB); PG8_STAGE(PG8_SA(0, 0), cA, voffA); PG8_STAGE(PG8_SA(0, 1), cA + hstepA, voffA);
    if (wr == 1) PG8_BAR;
    PG8_WAIT_V(2); PG8_BAR;
    PG8_STAGE(PG8_SB(1, 0), cB + kstep, voffB); PG8_STAGE(PG8_SA(1, 0), cA + kstep, voffA); PG8_STAGE(PG8_SB(1, 1), cB + hstepB + kstep, voffB);
    PG8_WAIT_V(6); PG8_BAR;
    for (;;) {
        const bool has_next = S.next(ui + 1, nxt);
        const char* nA = has_next ? (const char*)g.A + (size_t)(nxt.z & g.amask) * g.batchA + (size_t)nxt.pm * tstepA : cA;
        const char* nB = has_next ? (const char*)g.Bt + (size_t)nxt.z * g.batchB + (size_t)nxt.pn * tstepB : cB;
        for (int t = 0; t < nt; t += 2) {
            const bool last = (t == nt - 2);
            const char* a1 = cA + (size_t)(t + 1) * kstep;
            const char* a2 = last ? nA : cA + (size_t)(t + 2) * kstep; const char* b2 = last ? nB : cB + (size_t)(t + 2) * kstep;
            const char* a3 = a2 + kstep; const char* b3 = b2 + kstep;
            PG8_LDB(B0, 0, 0); PG8_LDB(B1, 0, 1); PG8_SCHED; PG8_LDA(At, 0, 0); PG8_STAGE(PG8_SA(1, 1), a1 + hstepA, voffA);
            PG8_WAIT_V(8); PG8_WAIT_L(0); PG8_BAR; PG8_MMA(0, 0, At, B0); PG8_MMA(0, 1, At, B1); PG8_BAR; PG8_SCHED;
            PG8_LDA(At, 0, 1); PG8_STAGE(PG8_SB(0, 0), b2, voffB); PG8_STAGE(PG8_SB(0, 1), b2 + hstepB, voffB); PG8_STAGE(PG8_SA(0, 0), a2, voffA);
            PG8_WAIT_V(8); PG8_WAIT_L(0); PG8_BAR; PG8_MMA(1, 0, At, B0); PG8_MMA(1, 1, At, B1); PG8_BAR; PG8_SCHED;
            PG8_LDB(B0, 1, 0); PG8_LDB(B1, 1, 1); PG8_SCHED; PG8_LDA(At, 1, 0); PG8_STAGE(PG8_SA(0, 1), a2 + hstepA, voffA);
            PG8_WAIT_V(8); PG8_WAIT_L(0); PG8_BAR; PG8_MMA(0, 0, At, B0); PG8_MMA(0, 1, At, B1); PG8_BAR; PG8_SCHED;
            PG8_LDA(At, 1, 1); PG8_STAGE(PG8_SB(1, 0), b3, voffB); PG8_STAGE(PG8_SB(1, 1), b3 + hstepB, voffB); PG8_STAGE(PG8_SA(1, 0), a3, voffA);
            PG8_WAIT_V(8); PG8_WAIT_L(0); PG8_BAR; PG8_MMA(1, 0, At, B0); PG8_MMA(1, 1, At, B1); PG8_BAR; PG8_SCHED;
        }
        if (wr == 0) PG8_BAR;
        E(acc, cur, wr, wc, fr, fq);
        if (!has_next) break;
#pragma unroll
        for (int a = 0; a < 2; ++a)
#pragma unroll
            for (int b = 0; b < 2; ++b)
#pragma unroll
                for (int m = 0; m < 4; ++m)
#pragma unroll
                    for (int n = 0; n < 2; ++n) acc[a][b][m][n] = (f32x4){0.f, 0.f, 0.f, 0.f};
        cur = nxt; cA = nA; cB = nB; ++ui;
        if (wr == 1) PG8_BAR;
    }
    PG8_WAIT_V(0);
    PG8_BAR;
#undef PG8_SA
#undef PG8_SB
#undef PG8_STAGE
#undef PG8_LDA
#undef PG8_LDB
#undef PG8_MMA
#undef PG8_WAIT_V
#undef PG8_WAIT_L
#undef PG8_BAR
#undef PG8_SCHED
}
}
using pg8::Unit;
typedef f32x4 Acc[2][2][4][2];

#define EPI_ROWLOOP for (int ai = 0; ai < 2; ++ai) _Pragma("unroll") for (int m = 0; m < 4; ++m)
#define EPI_ROW (u.pm * 256 + ai * 128 + wr * 64 + m * 16 + fr)

struct EpiInProj {
    static constexpr bool PERM = true;
    bf16_t* A5; bf16_t* GATES;
    __device__ __forceinline__ void operator()(const Acc& acc, const Unit& u, int wr, int wc, int fr, int fq) const {
        const int cw = wc * 32 + 8 * fq;
        if (u.pn < 2) {
#pragma unroll
            EPI_ROWLOOP { const int row = EPI_ROW;
#pragma unroll
                for (int bj = 0; bj < 2; ++bj) { const int col = u.pn * 256 + bj * 128 + cw; const int gq = col >> 4, h0 = col & 15;
                    bf16_t* dst = A5 + ((size_t)gq * 1024 + (row >> 5)) * 768 + (row & 31) * 16 + h0;
                    *(u32x4*)dst = pack8(acc[ai][bj][m][0], acc[ai][bj][m][1]); } }
        } else {
#pragma unroll
            EPI_ROWLOOP { const int row = EPI_ROW; bf16_t* rowp = GATES + (size_t)row * 4096 + (u.pn - 2) * 256 + cw;
#pragma unroll
                for (int bj = 0; bj < 2; ++bj) { f32x4 v0 = acc[ai][bj][m][0], v1 = acc[ai][bj][m][1];
#pragma unroll
                    for (int j = 0; j < 4; ++j) { v0[j] = fsigmoid(v0[j]); v1[j] = fsigmoid(v1[j]); }
                    __builtin_nontemporal_store(pack8(v0, v1), (u32x4*)(rowp + bj * 128)); } }
        }
    }
};
struct EpiBf16 {
    static constexpr bool PERM = true;
    bf16_t* O; int ldc;
    __device__ __forceinline__ void operator()(const Acc& acc, const Unit& u, int wr, int wc, int fr, int fq) const {
        const int cw = u.pn * 256 + wc * 32 + 8 * fq;
#pragma unroll
        EPI_ROWLOOP { bf16_t* rowp = O + (size_t)EPI_ROW * ldc + cw;
#pragma unroll
            for (int bj = 0; bj < 2; ++bj) *(u32x4*)(rowp + bj * 128) = pack8(acc[ai][bj][m][0], acc[ai][bj][m][1]); }
    }
};
struct EpiF32 {
    static constexpr bool PERM = false;
    float* C;
    __device__ __forceinline__ void operator()(const Acc& acc, const Unit& u, int wr, int wc, int fr, int fq) const {
        const int cw = u.pn * 256 + wc * 32 + 4 * fq;
#pragma unroll
        EPI_ROWLOOP { float* rowp = C + ((size_t)u.z * 1024 + EPI_ROW) * 256 + cw;
#pragma unroll
            for (int bj = 0; bj < 2; ++bj)
#pragma unroll
                for (int n = 0; n < 2; ++n) *(f32x4*)(rowp + bj * 128 + n * 16) = acc[ai][bj][m][n]; }
    }
};
struct EpiDFT {
    static constexpr bool PERM = true;
    bf16_t* V; const float* UNQ;
    __device__ __forceinline__ void operator()(const Acc& acc, const Unit& u, int wr, int wc, int fr, int fq) const {
        const float sc = 0.011048543456039806f;
        const int cw = wc * 32 + 8 * fq; const int b = u.z >> 2, part = u.z & 3;
        f32x4 nq[2][2];
#pragma unroll
        for (int bj = 0; bj < 2; ++bj) { const float* np = UNQ + (size_t)(part * 4 + b) * 1536 + u.pn * 256 + bj * 128 + cw; const float sg = (fr & 1) ? -1.f : 1.f;
            nq[bj][0] = *(const f32x4*)np * sg; nq[bj][1] = *(const f32x4*)(np + 4) * sg; }
#pragma unroll
        EPI_ROWLOOP { const int k = 2 * EPI_ROW + (part & 1);
            bf16_t* rowp = V + ((size_t)b * 4096 + k) * 3072 + (part >> 1) * 1536 + u.pn * 256 + cw;
#pragma unroll
            for (int bj = 0; bj < 2; ++bj) *(u32x4*)(rowp + bj * 128) = pack8((acc[ai][bj][m][0] + nq[bj][0]) * sc, (acc[ai][bj][m][1] + nq[bj][1]) * sc); }
    }
};
struct EpiBf16Z {
    static constexpr bool PERM = true;
    bf16_t* O; int ldc;
    __device__ __forceinline__ void operator()(const Acc& acc, const Unit& u, int wr, int wc, int fr, int fq) const {
        const int cw = u.z * 256 + wc * 32 + 8 * fq;
#pragma unroll
        EPI_ROWLOOP { bf16_t* rowp = O + (size_t)EPI_ROW * ldc + cw;
#pragma unroll
            for (int bj = 0; bj < 2; ++bj) *(u32x4*)(rowp + bj * 128) = pack8(acc[ai][bj][m][0], acc[ai][bj][m][1]); }
    }
};
struct EpiMergePQ {
    static constexpr bool PERM = true;
    const bf16_t* PB; const bf16_t* G; bf16_t* MG;
    __device__ __forceinline__ void operator()(const Acc& acc, const Unit& u, int wr, int wc, int fr, int fq) const {
        const int cw = u.pn * 256 + wc * 32 + 8 * fq;
#pragma unroll
        for (int ai = 0; ai < 2; ++ai)
#pragma unroll
        for (int mh = 0; mh < 2; ++mh) {
            u32x4 pw[2][2], g1[2][2], g2[2][2];
#pragma unroll
            for (int mm = 0; mm < 2; ++mm) { const int m = 2 * mh + mm; const int r = EPI_ROW; const int b = r >> 12, k = r & 4095;
                const size_t t1 = (size_t)b * 8192 + k, t2 = (size_t)b * 8192 + ((8192 - k) & 8191);
#pragma unroll
                for (int bj = 0; bj < 2; ++bj) { const int col = cw + bj * 128;
                    pw[mm][bj] = *(const u32x4*)(PB + (size_t)r * 2048 + col); g1[mm][bj] = *(const u32x4*)(G + t1 * 4096 + col); g2[mm][bj] = *(const u32x4*)(G + t2 * 4096 + col); } }
            asm volatile("" ::: "memory");
#pragma unroll
            for (int mm = 0; mm < 2; ++mm) { const int m = 2 * mh + mm; const int r = EPI_ROW; const int b = r >> 12, k = r & 4095;
                const size_t t1 = (size_t)b * 8192 + k, t2 = (size_t)b * 8192 + ((8192 - k) & 8191);
#pragma unroll
                for (int bj = 0; bj < 2; ++bj) { const int col = cw + bj * 128; const u32x4 pq = pw[mm][bj], ga = g1[mm][bj], gb = g2[mm][bj];
                    const f32x4 p0 = {bflo(pq.x), bfhi(pq.x), bflo(pq.y), bfhi(pq.y)}, p1 = {bflo(pq.z), bfhi(pq.z), bflo(pq.w), bfhi(pq.w)};
                    const f32x4 a0 = {bflo(ga.x), bfhi(ga.x), bflo(ga.y), bfhi(ga.y)}, a1 = {bflo(ga.z), bfhi(ga.z), bflo(ga.w), bfhi(ga.w)};
                    const f32x4 c0 = {bflo(gb.x), bfhi(gb.x), bflo(gb.y), bfhi(gb.y)}, c1 = {bflo(gb.z), bfhi(gb.z), bflo(gb.w), bfhi(gb.w)};
                    const f32x4 q0 = acc[ai][bj][m][0], q1 = acc[ai][bj][m][1];
                    *(u32x4*)(MG + t1 * 2048 + col) = pack8(a0 * (p0 + q0) * 0.0625f, a1 * (p1 + q1) * 0.0625f);
                    if (k != 0) *(u32x4*)(MG + t2 * 2048 + col) = pack8(c0 * (p0 - q0) * 0.0625f, c1 * (p1 - q1) * 0.0625f); } }
            asm volatile("" ::: "memory");
        }
    }
};
struct EpiS5Out {
    static constexpr bool PERM = true;
    bf16_t* Y5;
    __device__ __forceinline__ void operator()(const Acc& acc, const Unit& u, int wr, int wc, int fr, int fq) const {
        const int cw = u.pn * 256 + wc * 32 + 8 * fq;
#pragma unroll
        EPI_ROWLOOP { const int r = EPI_ROW; const int b = r >> 8, c = r & 255;
#pragma unroll
            for (int bj = 0; bj < 2; ++bj) { const int col = cw + bj * 128; const int t = col >> 4, h0 = col & 15;
                f32x4 v0 = acc[ai][bj][m][0], v1 = acc[ai][bj][m][1];
#pragma unroll
                for (int j = 0; j < 4; ++j) { v0[j] = gelu_tanh(v0[j]); v1[j] = gelu_tanh(v1[j]); }
                *(u32x4*)(Y5 + (size_t)(b * 8192 + c * 32 + t) * 512 + u.z * 16 + h0) = pack8(v0, v1); } }
    }
};
template <int MODE> struct EpiGated {
    static constexpr bool PERM = true;
    bf16_t* O; int ldc;
    __device__ __forceinline__ void operator()(const Acc& acc, const Unit& u, int wr, int wc, int fr, int fq) const {
        const int cw = u.pn * 128 + wc * 32 + 8 * fq;
#pragma unroll
        EPI_ROWLOOP { bf16_t* rowp = O + (size_t)EPI_ROW * ldc + cw;
            f32x4 v0, v1;
#pragma unroll
            for (int j = 0; j < 4; ++j) {
                const float p0 = acc[ai][0][m][0][j], q0 = acc[ai][1][m][0][j], p1 = acc[ai][0][m][1][j], q1 = acc[ai][1][m][1][j];
                if (MODE == 0) { v0[j] = p0 * fsigmoid(q0); v1[j] = p1 * fsigmoid(q1); }
                else { v0[j] = p0 * fsigmoid(p0) * q0; v1[j] = p1 * fsigmoid(p1) * q1; } }
            *(u32x4*)rowp = pack8(v0, v1); }
    }
};
template <bool ADD> struct EpiMerge {
    static constexpr bool PERM = true;
    const bf16_t* G; bf16_t* MG;
    __device__ __forceinline__ void operator()(const Acc& acc, const Unit& u, int wr, int wc, int fr, int fq) const {
        const int cw = u.pn * 256 + wc * 32 + 8 * fq;
#pragma unroll
        for (int ai = 0; ai < 2; ++ai) {
            u32x4 gw[4][2], ow[4][2];
#pragma unroll
            for (int m = 0; m < 4; ++m)
#pragma unroll
                for (int bj = 0; bj < 2; ++bj) { const int row = EPI_ROW; const int col = cw + bj * 128;
                    gw[m][bj] = *(const u32x4*)(G + (size_t)row * 4096 + col);
                    if (ADD) ow[m][bj] = *(const u32x4*)(MG + (size_t)row * 2048 + col); }
            asm volatile("" ::: "memory");
#pragma unroll
            for (int m = 0; m < 4; ++m)
#pragma unroll
                for (int bj = 0; bj < 2; ++bj) { const int row = EPI_ROW; const int col = cw + bj * 128; const u32x4 g4 = gw[m][bj];
                    f32x4 v0 = acc[ai][bj][m][0], v1 = acc[ai][bj][m][1];
                    v0[0] *= bflo(g4.x); v0[1] *= bfhi(g4.x); v0[2] *= bflo(g4.y); v0[3] *= bfhi(g4.y);
                    v1[0] *= bflo(g4.z); v1[1] *= bfhi(g4.z); v1[2] *= bflo(g4.w); v1[3] *= bfhi(g4.w);
                    if (ADD) { const u32x4 o4 = ow[m][bj];
                        v0[0] += bflo(o4.x); v0[1] += bfhi(o4.x); v0[2] += bflo(o4.y); v0[3] += bfhi(o4.y);
                        v1[0] += bflo(o4.z); v1[1] += bfhi(o4.z); v1[2] += bflo(o4.w); v1[3] += bfhi(o4.w); }
                    *(u32x4*)(MG + (size_t)row * 2048 + col) = pack8(v0, v1); }
            asm volatile("" ::: "memory");
        }
    }
};
struct EpiResidB {
    static constexpr bool PERM = true;
    const bf16_t* X1B; bf16_t* X2B; const float* gate;
    __device__ __forceinline__ void operator()(const Acc& acc, const Unit& u, int wr, int wc, int fr, int fq) const {
        const int cw = u.pn * 256 + wc * 32 + 8 * fq; const int b = u.pm >> 5;
        f32x4 gv[2][2];
#pragma unroll
        for (int bj = 0; bj < 2; ++bj)
#pragma unroll
            for (int n = 0; n < 2; ++n) gv[bj][n] = *(const f32x4*)(gate + (size_t)b * 12288 + cw + bj * 128 + 4 * n);
#pragma unroll
        for (int ai = 0; ai < 2; ++ai) {
            u32x4 xw[4][2];
#pragma unroll
            for (int m = 0; m < 4; ++m)
#pragma unroll
                for (int bj = 0; bj < 2; ++bj) xw[m][bj] = *(const u32x4*)(X1B + (size_t)EPI_ROW * 2048 + cw + bj * 128);
            asm volatile("" ::: "memory");
#pragma unroll
            for (int m = 0; m < 4; ++m)
#pragma unroll
                for (int bj = 0; bj < 2; ++bj) { const u32x4 w = xw[m][bj];
                    f32x4 v0 = gv[bj][0] * acc[ai][bj][m][0], v1 = gv[bj][1] * acc[ai][bj][m][1];
                    v0[0] += bflo(w.x); v0[1] += bfhi(w.x); v0[2] += bflo(w.y); v0[3] += bfhi(w.y);
                    v1[0] += bflo(w.z); v1[1] += bfhi(w.z); v1[2] += bflo(w.w); v1[3] += bfhi(w.w);
                    *(u32x4*)(X2B + (size_t)EPI_ROW * 2048 + cw + bj * 128) = pack8(v0, v1); }
            asm volatile("" ::: "memory");
        }
    }
};
struct EpiResidX {
    static constexpr bool PERM = true;
    const float* base; bf16_t* X1B; const float* gate; const float* gw; bf16_t* XS; float* SSQ;
    __device__ __forceinline__ void operator()(const Acc& acc, const Unit& u, int wr, int wc, int fr, int fq) const {
        const int cw = u.pn * 256 + wc * 32 + 8 * fq; const int b = u.pm >> 5;
        f32x4 gv[2][2], gx[2][2];
#pragma unroll
        for (int bj = 0; bj < 2; ++bj)
#pragma unroll
            for (int n = 0; n < 2; ++n) { gv[bj][n] = *(const f32x4*)(gate + (size_t)b * 12288 + cw + bj * 128 + 4 * n); gx[bj][n] = *(const f32x4*)(gw + (size_t)b * 2048 + cw + bj * 128 + 4 * n); }
#pragma unroll
        EPI_ROWLOOP { const int row = EPI_ROW; const size_t off = (size_t)row * 2048 + cw; float t = 0.f;
            f32x4 bs[2][2];
#pragma unroll
            for (int bj = 0; bj < 2; ++bj)
#pragma unroll
                for (int n = 0; n < 2; ++n) bs[bj][n] = *(const f32x4*)(base + off + bj * 128 + 4 * n);
            asm volatile("" ::: "memory");
#pragma unroll
            for (int bj = 0; bj < 2; ++bj) { const f32x4 x0 = bs[bj][0] + gv[bj][0] * acc[ai][bj][m][0], x1 = bs[bj][1] + gv[bj][1] * acc[ai][bj][m][1];
                t += (x0[0] * x0[0] + x0[1] * x0[1]) + (x0[2] * x0[2] + x0[3] * x0[3]) + (x1[0] * x1[0] + x1[1] * x1[1]) + (x1[2] * x1[2] + x1[3] * x1[3]);
                *(u32x4*)(X1B + off + bj * 128) = pack8(x0, x1);
                *(u32x4*)(XS + off + bj * 128) = pack8(x0 * gx[bj][0], x1 * gx[bj][1]); }
            t += __shfl_xor(t, 16); t += __shfl_xor(t, 32);
            if (fq == 0) SSQ[(size_t)row * 32 + u.pn * 4 + wc] = t;
            asm volatile("" ::: "memory"); }
    }
};
struct EpiSwiGLU {
    static constexpr bool PERM = true;
    bf16_t* O; const float* RSTD; const float* BIAS;
    __device__ __forceinline__ void operator()(const Acc& acc, const Unit& u, int wr, int wc, int fr, int fq) const {
        const int cw = u.pn * 128 + wc * 32 + 8 * fq; const int b = u.pm >> 5;
        f32x4 bia[2][2];
#pragma unroll
        for (int bj = 0; bj < 2; ++bj)
#pragma unroll
            for (int n = 0; n < 2; ++n) bia[bj][n] = *(const f32x4*)(BIAS + (size_t)b * 11264 + u.pn * 256 + bj * 128 + wc * 32 + 8 * fq + 4 * n);
        float rsv[2][4];
#pragma unroll
        EPI_ROWLOOP rsv[ai][m] = RSTD[EPI_ROW];
        asm volatile("" ::: "memory");
#pragma unroll
        EPI_ROWLOOP { const int row = EPI_ROW; const float rs = rsv[ai][m]; bf16_t* rowp = O + (size_t)row * DFF + cw;
            f32x4 v0, v1;
#pragma unroll
            for (int j = 0; j < 4; ++j) {
                const float p0 = rs * acc[ai][0][m][0][j] + bia[0][0][j], q0 = rs * acc[ai][1][m][0][j] + bia[1][0][j];
                const float p1 = rs * acc[ai][0][m][1][j] + bia[0][1][j], q1 = rs * acc[ai][1][m][1][j] + bia[1][1][j];
                v0[j] = p0 * fsigmoid(p0) * q0; v1[j] = p1 * fsigmoid(p1) * q1; }
            __builtin_nontemporal_store(pack8(v0, v1), (u32x4*)rowp); }
    }
};

struct Ctx {
    LAS unsigned char* lds; int tid, lane, wave, G, bid;
    const float *x, *c, *w_ada, *b_ada, *norm_mix, *w_in, *lam_re, *lam_im, *log_step, *b_re, *b_im, *c_re, *c_im, *s5_d, *w_glu, *w_bs5, *w_bfn, *w_out, *norm_ffn, *w_ffi, *w_ffo, *norm_final;
    float* out; unsigned char* ws;
};

__device__ __forceinline__ void p0_adaln(const Ctx& F) {
    LAS float* cact = (LAS float*)F.lds;
    LAS float* red = (LAS float*)(F.lds + 32768);
    float* mod = (float*)(F.ws + WS_MOD);
    for (int i = F.tid; i < 8192; i += NTHR) { const float v = F.c[i]; cact[i] = v / (1.0f + __expf(-v)); }
    __syncthreads();
    for (int chunk = F.bid; chunk < 256; chunk += F.G) {
        const int j0 = chunk * 48, q = F.tid % 12, rl = F.tid / 12;
        f32x4 a0 = {0.f, 0.f, 0.f, 0.f}, a1 = a0, a2 = a0, a3 = a0;
        if (rl < 42) {
#pragma unroll 7
            for (int k = rl; k < 2048; k += 42) { const f32x4 w = *(const f32x4*)(F.w_ada + (size_t)k * 12288 + j0 + 4 * q);
                a0 += cact[k] * w; a1 += cact[2048 + k] * w; a2 += cact[4096 + k] * w; a3 += cact[6144 + k] * w; }
            *(LAS f32x4*)(red + (rl * 4 + 0) * 48 + 4 * q) = a0; *(LAS f32x4*)(red + (rl * 4 + 1) * 48 + 4 * q) = a1;
            *(LAS f32x4*)(red + (rl * 4 + 2) * 48 + 4 * q) = a2; *(LAS f32x4*)(red + (rl * 4 + 3) * 48 + 4 * q) = a3;
        }
        __syncthreads();
        if (F.tid < 192) { const int b = F.tid / 48, j = F.tid % 48; float s = 0.f;
            for (int r = 0; r < 42; ++r) s += red[(r * 4 + b) * 48 + j];
            mod[b * 12288 + j0 + j] = s + F.b_ada[j0 + j]; }
        __syncthreads();
    }
}

__device__ __forceinline__ void p0_s5_item(const Ctx& F, int item) {
    LAS float* bbr = (LAS float*)F.lds; LAS float* bbi = bbr + 1024; LAS float* cre = bbi + 1024; LAS float* cim = cre + 1024; LAS float* pwr = cim + 1024; LAS float* pwi = pwr + 1024;
    const int d = item >> 6, g = (item >> 1) & 31, q = item & 1, dg = d * 32 + g;
    const float dt = expf(F.log_step[dg]);
#pragma unroll
    for (int i = 0; i < 2; ++i) { const int e = F.tid + NTHR * i;
        { const int n = e >> 4, hp = e & 15; const float lr = F.lam_re[dg * 64 + n], li = F.lam_im[dg * 64 + n];
          const float mag = expf(lr * dt); float s, c0; sincosf(li * dt, &s, &c0); const float lbr = mag * c0, lbi = mag * s, den = lr * lr + li * li, nr = lbr - 1.0f, ni = lbi;
          const float cr = (nr * lr + ni * li) / den, ci = (ni * lr - nr * li) / den;
          const float br = F.b_re[((size_t)dg * 64 + n) * 16 + hp], bi = F.b_im[((size_t)dg * 64 + n) * 16 + hp];
          bbr[e] = cr * br - ci * bi; bbi[e] = cr * bi + ci * br;
          const int tl = hp; const float tau = (float)(16 * q + tl); const float pm = expf(lr * dt * tau); float ps, pc; sincosf(li * dt * tau, &ps, &pc); pwr[e] = pm * pc; pwi[e] = pm * ps; }
        { cre[e] = F.c_re[(size_t)dg * 1024 + e]; cim[e] = F.c_im[(size_t)dg * 1024 + e]; }
    }
    __syncthreads();
    { float* ktab = (float*)(F.ws + WS_KTAB);
      const int hh = F.tid & 255, h = hh >> 4, hp = hh & 15, sub = F.tid >> 8; float acc[8];
#pragma unroll
      for (int i = 0; i < 8; ++i) acc[i] = 0.f;
      for (int n = 0; n < 64; ++n) { const float Cr = cre[h * 64 + n], Ci = cim[h * 64 + n], Br = bbr[n * 16 + hp], Bi = bbi[n * 16 + hp];
          const float cbr = Cr * Br - Ci * Bi, cbi = Cr * Bi + Ci * Br;
#pragma unroll
          for (int i = 0; i < 8; ++i) { const int tl = 2 * i + sub; acc[i] += pwr[n * 16 + tl] * cbr - pwi[n * 16 + tl] * cbi; } }
#pragma unroll
      for (int i = 0; i < 8; ++i) ktab[((size_t)dg * 64 + 16 * q + 2 * i + sub) * 256 + hh] = acc[i]; }
    { bf16_t* bst = (bf16_t*)(F.ws + WS_BST);
#pragma unroll
      for (int i = 0; i < 8; ++i) { const int ch = F.tid + NTHR * i; const int rowi = ch >> 5, cc = ch & 31, tl = cc >> 1, hhalf = cc & 1, n = rowi & 63, im = rowi >> 6;
          const int tau = 16 * q + tl, tp = d == 0 ? 31 - tau : tau; const float pr = pwr[n * 16 + tl], pi = pwi[n * 16 + tl]; float v[8];
#pragma unroll
          for (int j = 0; j < 8; ++j) { const float Br = bbr[n * 16 + 8 * hhalf + j], Bi = bbi[n * 16 + 8 * hhalf + j]; v[j] = im ? (pr * Bi + pi * Br) : (pr * Br - pi * Bi); }
          u32x4 w; w.x = pk2(v[0], v[1]); w.y = pk2(v[2], v[3]); w.z = pk2(v[4], v[5]); w.w = pk2(v[6], v[7]);
          *(u32x4*)(bst + ((size_t)g * 256 + d * 128 + im * 64 + n) * 512 + tp * 16 + 8 * hhalf) = w; } }
    __syncthreads();
}

__device__ __forceinline__ void p0_transpose_item(const float* W, int K, int N, bf16_t* WT, int k0, int n0, int drow0, LAS float* scr, int lane) {
#pragma unroll 8
    for (int i = 0; i < 32; ++i) { const int kk = 2 * i + (lane >> 5); scr[kk * 33 + (lane & 31)] = W[(size_t)(k0 + kk) * N + n0 + (lane & 31)]; }
    asm volatile("s_waitcnt lgkmcnt(0)" ::: "memory");
    const int c = lane & 7;
#pragma unroll
    for (int j = 0; j < 4; ++j) { const int n = (lane >> 3) + 8 * j; const LAS float* s = scr + (8 * c) * 33 + n;
        u32x4 o; o.x = pk2(s[0 * 33], s[1 * 33]); o.y = pk2(s[2 * 33], s[3 * 33]); o.z = pk2(s[4 * 33], s[5 * 33]); o.w = pk2(s[6 * 33], s[7 * 33]);
        *(u32x4*)(WT + (size_t)(drow0 + n) * K + k0 + 8 * c) = o; }
    asm volatile("s_waitcnt lgkmcnt(0)" ::: "memory");
}
__device__ __forceinline__ void p0_weights(const Ctx& F) {
    LAS float* scr = (LAS float*)(F.lds + F.wave * 8448);
    const int gw = F.bid * 8 + F.wave, NGW = F.G * 8;
    constexpr int I_IN = 32 * 192, I_GLU = 8 * 32, I_BS5 = 8 * 64, I_BFN = 24 * 64, I_OUT = 32 * 64, I_FFI = 32 * 352, I_FFO = 88 * 64;
    constexpr int NITEMS = I_IN + I_GLU + I_BS5 + I_BFN + I_OUT + I_FFI + I_FFO;
    for (int it = gw; it < NITEMS; it += NGW) {
        int r = it;
        if (r < I_IN) { const int nb = r % 192, kb = r / 192, n0 = nb * 32; const int dr = n0 < 512 ? n0 : (n0 < 2048 ? n0 + 4096 : n0 - 1536);
            p0_transpose_item(F.w_in, 2048, 6144, (bf16_t*)(F.ws + WS_WIN), kb * 64, n0, dr, scr, F.lane); continue; } r -= I_IN;
        if (r < I_GLU) { const int nb = r % 32, kb = r / 32, n0 = nb * 32; const int j = n0 % 512, half = n0 / 512; const int dr = (j / 128) * 256 + half * 128 + (j % 128);
            p0_transpose_item(F.w_glu, 512, 1024, (bf16_t*)(F.ws + WS_WGLU), kb * 64, n0, dr, scr, F.lane); continue; } r -= I_GLU;
        if (r < I_BS5) { const int nb = r % 64, kb = r / 64; p0_transpose_item(F.w_bs5, 512, 2048, (bf16_t*)(F.ws + WS_WBS5), kb * 64, nb * 32, nb * 32, scr, F.lane); continue; } r -= I_BS5;
        if (r < I_BFN) { const int nb = r % 64, kb = r / 64; p0_transpose_item(F.w_bfn, 1536, 2048, (bf16_t*)(F.ws + WS_WBFN), kb * 64, nb * 32, nb * 32, scr, F.lane); continue; } r -= I_BFN;
        if (r < I_OUT) { const int nb = r % 64, kb = r / 64; p0_transpose_item(F.w_out, 2048, 2048, (bf16_t*)(F.ws + WS_WOUT), kb * 64, nb * 32, nb * 32, scr, F.lane); continue; } r -= I_OUT;
        if (r < I_FFI) { const int nb = r % 352, kb = r / 352, n0 = nb * 32; const int j = n0 % 5632, half = n0 / 5632; const int dr = (j / 128) * 256 + half * 128 + (j % 128);
            p0_transpose_item(F.w_ffi, 2048, 11264, (bf16_t*)(F.ws + WS_WFFI), kb * 64, n0, dr, scr, F.lane); continue; } r -= I_FFI;
        { const int nb = r % 64, kb = r / 64; p0_transpose_item(F.w_ffo, 5632, 2048, (bf16_t*)(F.ws + WS_WFFO), kb * 64, nb * 32, nb * 32, scr, F.lane); }
    }
}

__device__ __forceinline__ void p0_dft(const Ctx& F) {
    LAS float* tab = (LAS float*)F.lds;
    for (int i = F.tid; i < 8192; i += NTHR) tab[i] = cospif((float)i * (1.0f / 4096.0f));
    __syncthreads();
    bf16_t* dftm = (bf16_t*)(F.ws + WS_DFTM);
    const size_t nchunk = 8192ull * 256;
    for (size_t ch = (size_t)F.bid * NTHR + F.tid; ch < nchunk; ch += (size_t)F.G * NTHR) {
        const int r = (int)(ch >> 8), n0 = (int)(ch & 255) * 8; float v[8];
        const int part = r >> 11, j = r & 2047; const int k = 2 * j + (part & 1); const int sh = part >= 2 ? 2048 : 0;
#pragma unroll
        for (int q = 0; q < 8; ++q) v[q] = tab[(k * (n0 + q) + sh) & 8191];
        u32x4 w; w.x = pk2(v[0], v[1]); w.y = pk2(v[2], v[3]); w.z = pk2(v[4], v[5]); w.w = pk2(v[6], v[7]);
        *(u32x4*)(dftm + (size_t)r * 2048 + n0) = w;
    }
    bf16_t* cdm = (bf16_t*)(F.ws + WS_CDM);
    for (int ch = F.bid * NTHR + F.tid; ch < 512 * 64; ch += F.G * NTHR) {
        const int r = ch >> 6, c0 = (ch & 63) * 8; const int j = r & 255, neg = r >> 8; float v[8];
#pragma unroll
        for (int jj = 0; jj < 8; ++jj) { const int cc = c0 + jj; const int c = cc & 255; const int idx = ((j * c) & 255) * 32;
            v[jj] = cc < 256 ? tab[idx] : tab[(idx + (neg ? 2048 : 6144)) & 8191]; }
        u32x4 w; w.x = pk2(v[0], v[1]); w.y = pk2(v[2], v[3]); w.z = pk2(v[4], v[5]); w.w = pk2(v[6], v[7]);
        *(u32x4*)(cdm + (size_t)r * 512 + c0) = w;
    }
    __syncthreads();
}

__device__ __forceinline__ void p1_toep_item(const Ctx& F, int item) {
    const int g = item >> 5, t = item & 31;
    const float* ktab = (const float*)(F.ws + WS_KTAB); bf16_t* toep = (bf16_t*)(F.ws + WS_TOEP);
#pragma unroll
    for (int i = 0; i < 2; ++i) { const int ch = F.tid + NTHR * i; const int h = ch >> 6, kc = ch & 63, tp = kc >> 1, hh = kc & 1; f32x4 a, b;
        if (tp < t) { const float* s = ktab + ((size_t)(0 * 32 + g) * 64 + (t - tp)) * 256 + h * 16 + 8 * hh; a = *(const f32x4*)s; b = *(const f32x4*)(s + 4); }
        else if (tp > t) { const float* s = ktab + ((size_t)(1 * 32 + g) * 64 + (tp - t)) * 256 + h * 16 + 8 * hh; a = *(const f32x4*)s; b = *(const f32x4*)(s + 4); }
        else { const float* s0 = ktab + ((size_t)(0 * 32 + g) * 64) * 256 + h * 16 + 8 * hh; const float* s1 = ktab + ((size_t)(1 * 32 + g) * 64) * 256 + h * 16 + 8 * hh;
            a = *(const f32x4*)s0 + *(const f32x4*)s1; b = *(const f32x4*)(s0 + 4) + *(const f32x4*)(s1 + 4);
            const float dsk = F.s5_d[g * 16 + h]; const int hl = h - 8 * hh;
            if (hl >= 0 && hl < 4) a[hl] += dsk; else if (hl >= 4 && hl < 8) b[hl - 4] += dsk; }
        *(u32x4*)(toep + ((size_t)g * 512 + t * 16 + h) * 768 + tp * 16 + 8 * hh) = pack8(a, b); }
    if (F.tid < 256) { const int e = F.tid, d = e >> 7, h = (e >> 3) & 15, nc = e & 7, dg = d * 32 + g;
        const float dt = expf(F.log_step[dg]); const float p = d == 0 ? (float)(t + 1) : (float)(32 - t); f32x4 re0, re1, im0, im1;
#pragma unroll
        for (int j = 0; j < 8; ++j) { const int n = 8 * nc + j; const float lr = F.lam_re[dg * 64 + n], li = F.lam_im[dg * 64 + n];
            const float pm = expf(lr * dt * p); float ps, pc; sincosf(li * dt * p, &ps, &pc); const float pr = pm * pc, pi = pm * ps;
            const float Cr = F.c_re[((size_t)dg * 16 + h) * 64 + n], Ci = F.c_im[((size_t)dg * 16 + h) * 64 + n];
            const float re = Cr * pr - Ci * pi, imn = -(Cr * pi + Ci * pr);
            if (j < 4) { re0[j] = re; im0[j] = imn; } else { re1[j - 4] = re; im1[j - 4] = imn; } }
        bf16_t* dst = toep + ((size_t)g * 512 + t * 16 + h) * 768 + 512 + d * 128 + 8 * nc;
        *(u32x4*)dst = pack8(re0, re1); *(u32x4*)(dst + 64) = pack8(im0, im1); }
}

__device__ __forceinline__ void p1_ffn_mod(const Ctx& F) {
    const float* mod = (const float*)(F.ws + WS_MOD); float* gwp = (float*)(F.ws + WS_GW); float* bias = (float*)(F.ws + WS_BIAS);
    const bf16_t* wffi = (const bf16_t*)(F.ws + WS_WFFI);
    for (int i = F.bid * NTHR + F.tid; i < 8192; i += F.G * NTHR) gwp[i] = F.norm_ffn[i & 2047] * (1.0f + mod[(size_t)(i >> 11) * 12288 + 8192 + (i & 2047)]);
    const int gw = F.bid * 8 + F.wave, NGW = F.G * 8;
    for (int r = gw; r < 11264; r += NGW) { float s0 = 0.f, s1 = 0.f, s2 = 0.f, s3 = 0.f;
#pragma unroll
        for (int i = 0; i < 4; ++i) { const int k0 = (F.lane + 64 * i) * 8; const u32x4 w = *(const u32x4*)(wffi + (size_t)r * 2048 + k0);
            const float wv[8] = {bflo(w.x), bfhi(w.x), bflo(w.y), bfhi(w.y), bflo(w.z), bfhi(w.z), bflo(w.w), bfhi(w.w)};
#pragma unroll
            for (int b = 0; b < 4; ++b) { const float* sh = mod + (size_t)b * 12288 + 6144 + k0; const f32x4 a = *(const f32x4*)sh, c = *(const f32x4*)(sh + 4);
                const float t = (wv[0] * a[0] + wv[1] * a[1]) + (wv[2] * a[2] + wv[3] * a[3]) + (wv[4] * c[0] + wv[5] * c[1]) + (wv[6] * c[2] + wv[7] * c[3]);
                if (b == 0) s0 += t; else if (b == 1) s1 += t; else if (b == 2) s2 += t; else s3 += t; } }
        s0 = wave_sum(s0); s1 = wave_sum(s1); s2 = wave_sum(s2); s3 = wave_sum(s3);
        if (F.lane == 0) { bias[r] = s0; bias[11264 + r] = s1; bias[2 * 11264 + r] = s2; bias[3 * 11264 + r] = s3; } }
}
__device__ __forceinline__ void p10_rstd(const Ctx& F) {
    const float* ssq = (const float*)(F.ws + WS_SSQ); float* rstd = (float*)(F.ws + WS_RSTD);
    for (int row = F.bid * NTHR + F.tid; row < MTOK; row += F.G * NTHR) { const f32x4* p = (const f32x4*)(ssq + (size_t)row * 32); float t = 0.f;
#pragma unroll
        for (int i = 0; i < 8; ++i) { const f32x4 v = p[i]; t += (v[0] + v[1]) + (v[2] + v[3]); }
        rstd[row] = rsqrtf(t * (1.0f / 2048.0f) + 1e-6f); }
}
template <bool FINAL, int RB>
__device__ __forceinline__ void norm_rows(const Ctx& F, const float* src, const float* gamma, const float* shift, const float* scale, bf16_t* dstb, float* dstf) {
    const int gw = F.bid * 8 + F.wave, NGW = F.G * 8;
    for (int r0 = gw * 16; r0 < MTOK; r0 += NGW * 16) {
        const int b = r0 >> 13;
        f32x4 mul[8], add[8];
#pragma unroll
        for (int j = 0; j < 8; ++j) { const int col = 4 * F.lane + 256 * j; mul[j] = *(const f32x4*)(gamma + col);
            if (!FINAL) { mul[j] = mul[j] * (*(const f32x4*)(scale + (size_t)b * 12288 + col) + 1.0f); add[j] = *(const f32x4*)(shift + (size_t)b * 12288 + col); } }
        for (int r = r0; r < r0 + 16; r += RB) {
            f32x4 v[RB][8]; float s[RB];
#pragma unroll
            for (int q = 0; q < RB; ++q) { const f32x4* xr = (const f32x4*)(src + (size_t)(r + q) * 2048) + F.lane;
#pragma unroll
                for (int j = 0; j < 8; ++j) v[q][j] = xr[64 * j]; }
            asm volatile("" ::: "memory");
#pragma unroll
            for (int q = 0; q < RB; ++q) { float t = 0.f;
#pragma unroll
                for (int j = 0; j < 8; ++j) t += (v[q][j][0] * v[q][j][0] + v[q][j][1] * v[q][j][1]) + (v[q][j][2] * v[q][j][2] + v[q][j][3] * v[q][j][3]);
                s[q] = rsqrtf(wave_sum(t) * (1.0f / 2048.0f) + 1e-6f); }
#pragma unroll
            for (int q = 0; q < RB; ++q) {
                if (FINAL) { f32x4* orow = (f32x4*)(dstf + (size_t)(r + q) * 2048) + F.lane;
#pragma unroll
                    for (int j = 0; j < 8; ++j) orow[64 * j] = v[q][j] * s[q] * mul[j];
                } else { u32x2* orow = (u32x2*)(dstb + (size_t)(r + q) * 2048) + F.lane;
#pragma unroll
                    for (int j = 0; j < 8; ++j) { const f32x4 o = v[q][j] * s[q] * mul[j] + add[j]; u32x2 w; w.x = pk2(o[0], o[1]); w.y = pk2(o[2], o[3]); orow[64 * j] = w; } } }
            asm volatile("" ::: "memory");
        }
    }
}

__device__ __forceinline__ void final_norm(const Ctx& F, const bf16_t* src, const float* gamma, float* dst) {
    const int gw = F.bid * 8 + F.wave, NGW = F.G * 8;
    f32x4 mul[4][2];
#pragma unroll
    for (int j = 0; j < 4; ++j) { const int col = (F.lane + 64 * j) * 8; mul[j][0] = *(const f32x4*)(gamma + col); mul[j][1] = *(const f32x4*)(gamma + col + 4); }
    for (int r0 = gw * 16; r0 < MTOK; r0 += NGW * 16) {
        for (int r = r0; r < r0 + 16; r += 2) {
            u32x4 w[2][4]; float s[2];
#pragma unroll
            for (int q = 0; q < 2; ++q)
#pragma unroll
                for (int j = 0; j < 4; ++j) w[q][j] = *(const u32x4*)(src + (size_t)(r + q) * 2048 + (F.lane + 64 * j) * 8);
            asm volatile("" ::: "memory");
#pragma unroll
            for (int q = 0; q < 2; ++q) { float t = 0.f;
#pragma unroll
                for (int j = 0; j < 4; ++j) { const u32x4 x = w[q][j]; const float a0 = bflo(x.x), a1 = bfhi(x.x), a2 = bflo(x.y), a3 = bfhi(x.y), a4 = bflo(x.z), a5 = bfhi(x.z), a6 = bflo(x.w), a7 = bfhi(x.w);
                    t += (a0 * a0 + a1 * a1) + (a2 * a2 + a3 * a3) + (a4 * a4 + a5 * a5) + (a6 * a6 + a7 * a7); }
                s[q] = rsqrtf(wave_sum(t) * (1.0f / 2048.0f) + 1e-6f); }
#pragma unroll
            for (int q = 0; q < 2; ++q)
#pragma unroll
                for (int j = 0; j < 4; ++j) { const u32x4 x = w[q][j]; float* o = dst + (size_t)(r + q) * 2048 + (F.lane + 64 * j) * 8;
                    const f32x4 lo = {bflo(x.x), bfhi(x.x), bflo(x.y), bfhi(x.y)}, hi = {bflo(x.z), bfhi(x.z), bflo(x.w), bfhi(x.w)};
                    *(f32x4*)o = lo * s[q] * mul[j][0]; *(f32x4*)(o + 4) = hi * s[q] * mul[j][1]; }
            asm volatile("" ::: "memory");
        }
    }
}
__device__ __forceinline__ void p3_fold(const Ctx& F) {
    LAS unsigned char* img = F.lds + F.wave * 16384;
    const int gw = F.bid * 8 + F.wave, NGW = F.G * 8;
    bf16_t* UT = (bf16_t*)(F.ws + WS_UT); float* vnyq = (float*)(F.ws + WS_VNYQ); float* unq = (float*)(F.ws + WS_UNQ);
    for (int row = gw; row < 6144; row += NGW) {
        const int ch = row >> 2, b = row & 3;
        bf16_t* rp = UT + (size_t)ch * 32768 + b * 8192;
        float alt = 0.f;
#pragma unroll
        for (int i = 0; i < 16; ++i) { const u32x4 w = *(const u32x4*)(rp + (size_t)(F.lane + 64 * i) * 8);
            *(LAS u32x4*)(img + (F.lane + 64 * i) * 16) = w;
            alt += (bflo(w.x) - bfhi(w.x)) + (bflo(w.y) - bfhi(w.y)) + (bflo(w.z) - bfhi(w.z)) + (bflo(w.w) - bfhi(w.w)); }
        alt = wave_sum(alt);
        asm volatile("s_waitcnt vmcnt(0) lgkmcnt(0)" ::: "memory");
        if (F.lane == 0) { const float u2048 = bf1(*(const LAS bf16_t*)(img + 2048 * 2)), u6144 = bf1(*(const LAS bf16_t*)(img + 6144 * 2));
            vnyq[b * 1536 + ch] = alt * 0.011048543456039806f;
            unq[(0 * 4 + b) * 1536 + ch] = u2048 + u6144; unq[(1 * 4 + b) * 1536 + ch] = 0.f; unq[(2 * 4 + b) * 1536 + ch] = 0.f; unq[(3 * 4 + b) * 1536 + ch] = -(u2048 - u6144); }
        const float u4096 = bf1(*(const LAS bf16_t*)(img + 4096 * 2));
#pragma unroll
        for (int i = 0; i < 4; ++i) { const int j = F.lane + 64 * i;
            const u32x4 wa = *(const LAS u32x4*)(img + j * 16), wq = *(const LAS u32x4*)(img + 8192 + j * 16);
            const float a[8] = {bflo(wa.x), bfhi(wa.x), bflo(wa.y), bfhi(wa.y), bflo(wa.z), bfhi(wa.z), bflo(wa.w), bfhi(wa.w)};
            const float qv[8] = {bflo(wq.x), bfhi(wq.x), bflo(wq.y), bfhi(wq.y), bflo(wq.z), bfhi(wq.z), bflo(wq.w), bfhi(wq.w)};
            float ee[8], eo[8], oe[8], oo[8];
#pragma unroll
            for (int t = 0; t < 8; ++t) { const int n = 8 * j + t;
                const float c = bf1(*(const LAS bf16_t*)(img + ((8192 - n) & 8191) * 2)), pv = bf1(*(const LAS bf16_t*)(img + (4096 - n) * 2));
                if (n == 0) { ee[t] = a[t] + u4096; eo[t] = a[t] - u4096; oe[t] = 0.f; oo[t] = 0.f; }
                else { const float s1 = a[t] + c, d1 = a[t] - c, s2 = pv + qv[t], d2 = pv - qv[t]; ee[t] = s1 + s2; eo[t] = s1 - s2; oe[t] = d1 - d2; oo[t] = d1 + d2; } }
            u32x4 w0, w1, w2, w3;
            w0.x = pk2(ee[0], ee[1]); w0.y = pk2(ee[2], ee[3]); w0.z = pk2(ee[4], ee[5]); w0.w = pk2(ee[6], ee[7]);
            w1.x = pk2(eo[0], eo[1]); w1.y = pk2(eo[2], eo[3]); w1.z = pk2(eo[4], eo[5]); w1.w = pk2(eo[6], eo[7]);
            w2.x = pk2(oe[0], oe[1]); w2.y = pk2(oe[2], oe[3]); w2.z = pk2(oe[4], oe[5]); w2.w = pk2(oe[6], oe[7]);
            w3.x = pk2(oo[0], oo[1]); w3.y = pk2(oo[2], oo[3]); w3.z = pk2(oo[4], oo[5]); w3.w = pk2(oo[6], oo[7]);
            *(u32x4*)(rp + (size_t)j * 8) = w0; *(u32x4*)(rp + 2048 + (size_t)j * 8) = w1; *(u32x4*)(rp + 4096 + (size_t)j * 8) = w2; *(u32x4*)(rp + 6144 + (size_t)j * 8) = w3; }
        asm volatile("s_waitcnt lgkmcnt(0)" ::: "memory");
    }
}
__device__ __forceinline__ void p4_scan(const Ctx& F, int blk0) {
    const int gt = (F.bid - blk0) * NTHR + F.tid; if (F.bid < blk0 || gt >= 16384) return;
    const int n = gt & 63, d = (gt >> 6) & 1, g = (gt >> 7) & 31, b = gt >> 12, dg = d * 32 + g;
    const float dt = expf(F.log_step[dg]); const float lr = F.lam_re[dg * 64 + n], li = F.lam_im[dg * 64 + n];
    const float pm = expf(lr * dt * 32.0f); float ps, pc; sincosf(li * dt * 32.0f, &ps, &pc); const float ar = pm * pc, ai = pm * ps;
    const float* sst = (const float*)(F.ws + WS_SST) + ((size_t)g * 1024 + b * 256) * 256 + d * 128 + n;
    bf16_t* a5 = (bf16_t*)(F.ws + WS_A5) + ((size_t)g * 1024 + b * 256) * 768 + 512 + d * 128 + n;
    float er = 0.f, ei = 0.f;
    for (int c0 = 0; c0 < 256; c0 += 32) { float sr[32], si[32];
#pragma unroll
        for (int j = 0; j < 32; ++j) { const int c = d == 0 ? (c0 + j) : (255 - c0 - j); sr[j] = sst[(size_t)c * 256]; si[j] = sst[(size_t)c * 256 + 64]; }
#pragma unroll
        for (int j = 0; j < 32; ++j) { const int c = d == 0 ? (c0 + j) : (255 - c0 - j);
            a5[(size_t)c * 768] = (bf16_t)(pk2(er, 0.f) & 0xffffu); a5[(size_t)c * 768 + 64] = (bf16_t)(pk2(ei, 0.f) & 0xffffu);
            const float nr = ar * er - ai * ei + sr[j], ni = ar * ei + ai * er + si[j]; er = nr; ei = ni; } }
}
__device__ __forceinline__ void p6_nyquist(const Ctx& F) {
    const int o = (F.bid - 32) * NTHR + F.tid; if (F.bid < 32 || o >= 8192) return;
    const int b = o >> 11, n = o & 2047;
    const float* vn = (const float*)(F.ws + WS_VNYQ) + b * 1536; const bf16_t* cwt = (const bf16_t*)(F.ws + WS_CSW) + (size_t)n * 1536; float s = 0.f;
    for (int c = 0; c < 1536; c += 8) { const u32x4 w = *(const u32x4*)(cwt + c); const f32x4 v0 = *(const f32x4*)(vn + c), v1 = *(const f32x4*)(vn + c + 4);
        s += (v0[0] * bflo(w.x) + v0[1] * bfhi(w.x)) + (v0[2] * bflo(w.y) + v0[3] * bfhi(w.y)) + (v1[0] * bflo(w.z) + v1[1] * bfhi(w.z)) + (v1[2] * bflo(w.w) + v1[3] * bfhi(w.w)); }
    const size_t tok = (size_t)b * 8192 + 4096;
    const float gt = bf1(((const bf16_t*)(F.ws + WS_GATES))[tok * 4096 + 2048 + n]);
    ((bf16_t*)(F.ws + WS_MG))[tok * 2048 + n] = (bf16_t)(pk2(gt * s * 0.0625f, 0.f) & 0xffffu);
}

struct Args { const float* in[22]; float* out; unsigned char* ws; int ph_lo, ph_hi; };

__global__ void __launch_bounds__(NTHR, 2) fwd_kernel(Args args) {
    extern __shared__ __attribute__((aligned(16))) unsigned char lds_raw[];
    cg::grid_group grid = cg::this_grid();
    Ctx F;
    F.lds = (LAS unsigned char*)lds_raw; F.tid = threadIdx.x; F.lane = F.tid & 63; F.wave = __builtin_amdgcn_readfirstlane(F.tid >> 6); F.G = gridDim.x; F.bid = blockIdx.x;
    F.x = args.in[0]; F.c = args.in[1]; F.w_ada = args.in[2]; F.b_ada = args.in[3]; F.norm_mix = args.in[4]; F.w_in = args.in[5];
    F.lam_re = args.in[6]; F.lam_im = args.in[7]; F.log_step = args.in[8]; F.b_re = args.in[9]; F.b_im = args.in[10]; F.c_re = args.in[11]; F.c_im = args.in[12];
    F.s5_d = args.in[13]; F.w_glu = args.in[14]; F.w_bs5 = args.in[15]; F.w_bfn = args.in[16]; F.w_out = args.in[17]; F.norm_ffn = args.in[18];
    F.w_ffi = args.in[19]; F.w_ffo = args.in[20]; F.norm_final = args.in[21]; F.out = args.out; F.ws = args.ws;
    unsigned char* ws = args.ws;
    const int lo = args.ph_lo, hi = args.ph_hi;
#define IN(k) (lo <= (k) && (k) < hi)
#define SEAM(k) do { if (IN(k) && IN((k) + 1)) xcd_barrier(xbar); } while (0)
    volatile LAS unsigned* xst = (volatile LAS unsigned*)(F.lds + LDS_STAGE);
    if (F.tid == 0) { xst[0] = 0u; xst[1] = 0u; }
    __syncthreads();
    XcdBarrier xbar; xbar.bar = (unsigned*)(ws + WS_BAR); xbar.x = 0; xbar.st = xst;
    if (hi - lo > 1) xbar = xcd_barrier_post((unsigned*)(ws + WS_BAR), xst);
    if (lo == 0x7fffffff) grid.sync();
    float* MOD = (float*)(ws + WS_MOD);
    bf16_t* H = (bf16_t*)(ws + WS_H); bf16_t* A5 = (bf16_t*)(ws + WS_A5); bf16_t* GATES = (bf16_t*)(ws + WS_GATES); bf16_t* UT = (bf16_t*)(ws + WS_UT);
    bf16_t* V = (bf16_t*)(ws + WS_V); bf16_t* YFN = (bf16_t*)(ws + WS_YFN); bf16_t* Y5 = (bf16_t*)(ws + WS_Y5); bf16_t* YS5 = (bf16_t*)(ws + WS_YS5);
    bf16_t* MG = (bf16_t*)(ws + WS_MG); bf16_t* ACT = (bf16_t*)(ws + WS_ACT);
    const bf16_t* WIN = (const bf16_t*)(ws + WS_WIN);

    if (IN(0)) {
        if (F.bid & 1) { p0_weights(F); __syncthreads(); }
        p0_adaln(F);
        for (int it = F.bid; it < 128; it += F.G) p0_s5_item(F, it);
        p0_dft(F);
        if (!(F.bid & 1)) p0_weights(F);
    }
    SEAM(0);
    if (IN(1)) {
        if (F.bid & 1) norm_rows<false, 2>(F, F.x, F.norm_mix, MOD + 0, MOD + 2048, H, nullptr);
        for (int it = F.bid; it < 1024; it += F.G) p1_toep_item(F, it);
        p1_ffn_mod(F);
        if (!(F.bid & 1)) norm_rows<false, 2>(F, F.x, F.norm_mix, MOD + 0, MOD + 2048, H, nullptr);
    }
    SEAM(1);
    if (IN(2)) {
        { pg8::Gemm g{H, WIN, 2048, 2048, 2048, 0, 0, 0xffff}; pg8::Order S; S.init(MTOK, 4608, 1, F.G, F.bid); EpiInProj E{A5, GATES}; pg8::gemm_phase(F.lds, g, S, E); }
        { pg8::Gemm g{WIN + (size_t)4608 * 2048, H, 2048, 2048, 2048, 0, 0, 0xffff}; pg8::Order S; S.init(1536, MTOK, 1, F.G, F.bid); EpiBf16 E{UT, MTOK}; pg8::gemm_phase(F.lds, g, S, E); }
    }
    SEAM(2);
    if (IN(3)) {
        { pg8::Gemm g{A5, (const bf16_t*)(ws + WS_BST), 768, 512, 512, 1024ull * 768 * 2, 256ull * 512 * 2, 0xffff}; pg8::Order S; S.init(1024, 256, 32, F.G, F.bid); EpiF32 E{(float*)(ws + WS_SST)}; pg8::gemm_phase(F.lds, g, S, E); }
        int kq = 256; asm volatile("" : "+s"(kq));
        { pg8::Gemm g{(const bf16_t*)(ws + WS_WBFN), (const bf16_t*)(ws + WS_CDM), 1536, 512, kq, 256ull * 2, 0, 0xffff}; pg8::Order S; S.init(2048, 256, 6, F.G, (F.bid + F.G - 128) % F.G);
          EpiBf16Z E{(bf16_t*)(ws + WS_CSW), 1536}; pg8::gemm_phase(F.lds, g, S, E); }
        { pg8::Gemm g{(const bf16_t*)(ws + WS_WBFN), (const bf16_t*)(ws + WS_CDM) + 256, 1536, 512, kq, 256ull * 2, 0, 0xffff}; pg8::Order S; S.init(2048, 256, 6, F.G, (F.bid + F.G - 128) % F.G);
          EpiBf16Z E{(bf16_t*)(ws + WS_CSW) + (size_t)2048 * 1536, 1536}; pg8::gemm_phase(F.lds, g, S, E); }
        const bool scan_early = (F.G == 256);
        unsigned* hand = (unsigned*)(ws + WS_BAR) + 64;
        if (scan_early && F.bid < 128) {
            asm volatile("s_waitcnt vmcnt(0)" ::: "memory"); __syncthreads();
            if (F.tid == 0) { __builtin_amdgcn_fence(__ATOMIC_RELEASE, "agent"); asm volatile("s_waitcnt vmcnt(0)" ::: "memory"); (void)xb_add(hand, 1u); }
        }
        p3_fold(F);
        if (scan_early && F.bid >= 176 && F.bid < 208) {
            if (F.tid == 0) { unsigned sp = 0u; while (xb_ld(hand) < 128u) { __builtin_amdgcn_s_sleep(2); if (++sp > (1u << 20)) break; }
                __builtin_amdgcn_fence(__ATOMIC_ACQUIRE, "agent"); asm volatile("s_waitcnt vmcnt(0)" ::: "memory"); }
            __syncthreads();
            p4_scan(F, 176);
        }
    }
    SEAM(3);
    if (IN(4)) {
        if (F.G != 256) p4_scan(F, 0);
        { pg8::Gemm g{(const bf16_t*)(ws + WS_DFTM), UT, 2048, MTOK, 2048, 2048ull * 2048 * 2, 2048ull * 2, 3}; pg8::Order S; S.init(2048, 1536, 16, F.G, F.bid); EpiDFT E{V, (const float*)(ws + WS_UNQ)}; pg8::gemm_phase(F.lds, g, S, E); }
    }
    SEAM(4);
    if (IN(5)) {
        { pg8::Gemm g{A5, (const bf16_t*)(ws + WS_TOEP), 768, 768, 768, 1024ull * 768 * 2, 512ull * 768 * 2, 0xffff}; pg8::Order S; S.init(1024, 512, 32, F.G, F.bid); EpiS5Out E{Y5}; pg8::gemm_phase(F.lds, g, S, E); }
        { pg8::Gemm g{V, (const bf16_t*)(ws + WS_CSW), 3072, 1536, 1536, 0, 0, 0xffff}; pg8::Order S; S.init(16384, 2048, 1, F.G, F.bid); EpiBf16 E{(bf16_t*)(ws + WS_PBUF), 2048}; pg8::gemm_phase(F.lds, g, S, E); }
    }
    SEAM(5);
    if (IN(6)) {
        { pg8::Gemm g{Y5, (const bf16_t*)(ws + WS_WGLU), 512, 512, 512, 0, 0, 0xffff}; pg8::Order S; S.init(MTOK, 1024, 1, F.G, F.bid); EpiGated<0> E{YS5, 512}; pg8::gemm_phase(F.lds, g, S, E); }
        p6_nyquist(F);
        { pg8::Gemm g{V + 1536, (const bf16_t*)(ws + WS_CSW) + (size_t)2048 * 1536, 3072, 1536, 1536, 0, 0, 0xffff}; pg8::Order S; S.init(16384, 2048, 1, F.G, F.bid); EpiMergePQ E{(const bf16_t*)(ws + WS_PBUF), GATES + 2048, MG}; pg8::gemm_phase(F.lds, g, S, E); }
    }
    SEAM(6);
    if (IN(7)) {
        { pg8::Gemm g{YS5, (const bf16_t*)(ws + WS_WBS5), 512, 512, 512, 0, 0, 0xffff}; pg8::Order S; S.init(MTOK, 2048, 1, F.G, F.bid); EpiMerge<true> E{GATES, MG}; pg8::gemm_phase(F.lds, g, S, E); }
    }
    SEAM(7);
    if (IN(9)) {
        pg8::Gemm g{MG, (const bf16_t*)(ws + WS_WOUT), 2048, 2048, 2048, 0, 0, 0xffff}; pg8::Order S; S.init(MTOK, 2048, 1, F.G, F.bid); EpiResidX E{F.x, (bf16_t*)F.out, MOD + 4096, (const float*)(ws + WS_GW), H, (float*)(ws + WS_SSQ)}; pg8::gemm_phase(F.lds, g, S, E);
    }
    SEAM(9);
    if (IN(10)) p10_rstd(F);
    SEAM(10);
    if (IN(11)) {
        pg8::Gemm g{H, (const bf16_t*)(ws + WS_WFFI), 2048, 2048, 2048, 0, 0, 0xffff}; pg8::Order S; S.init(MTOK, 11264, 1, F.G, F.bid); S.bres = (F.G == 256); EpiSwiGLU E{ACT, (const float*)(ws + WS_RSTD), (const float*)(ws + WS_BIAS)}; pg8::gemm_phase(F.lds, g, S, E);
    }
    SEAM(11);
    if (IN(12)) {
        pg8::Gemm g{ACT, (const bf16_t*)(ws + WS_WFFO), DFF, DFF, DFF, 0, 0, 0xffff}; pg8::Order S; S.init(MTOK, 2048, 1, F.G, F.bid); EpiResidB E{(const bf16_t*)F.out, MG, MOD + 10240}; pg8::gemm_phase(F.lds, g, S, E);
    }
    SEAM(12);
    if (IN(13)) final_norm(F, MG, F.norm_final, F.out);
#undef IN
#undef SEAM
}

extern "C" void kernel_launch(void* const* d_in, const int* in_sizes, int n_in, void* d_out, int out_size, void* d_ws, size_t ws_size, hipStream_t stream) {
    static int grid = 0;
    if (grid == 0) {
        int dev = 0, cus = 0, per_cu = 0;
        (void)hipGetDevice(&dev); (void)hipDeviceGetAttribute(&cus, hipDeviceAttributeMultiprocessorCount, dev);
        if (hipFuncSetAttribute((const void*)fwd_kernel, hipFuncAttributeMaxDynamicSharedMemorySize, LDS_BYTES) != hipSuccess) fprintf(stderr, "kernel_launch: hipFuncSetAttribute failed\n");
        if (hipOccupancyMaxActiveBlocksPerMultiprocessor(&per_cu, (const void*)fwd_kernel, NTHR, LDS_BYTES) != hipSuccess || per_cu < 1) per_cu = 1;
        (void)hipGetLastError();
        if (cus <= 0) cus = 256;
        grid = cus;
        if (ws_size < WS_END) fprintf(stderr, "kernel_launch: workspace too small: %zu < %zu\n", ws_size, (size_t)WS_END);
    }
    Args a{};
    for (int i = 0; i < 22; ++i) a.in[i] = (const float*)d_in[i];
    a.out = (float*)d_out; a.ws = (unsigned char*)d_ws;
#if ONE_LAUNCH
    (void)hipMemsetAsync((char*)d_ws + WS_BAR, 0, XCD_BAR_WORDS * 4, stream);
    a.ph_lo = 0; a.ph_hi = NPH;
    void* kargs[] = {&a};
    hipError_t e = hipLaunchCooperativeKernel((const void*)fwd_kernel, dim3(grid), dim3(NTHR), kargs, LDS_BYTES, stream);
    if (e != hipSuccess) fprintf(stderr, "cooperative launch failed: %s (grid %d)\n", hipGetErrorString(e), grid);
#else
    for (int ph = 0; ph < NPH; ++ph) { a.ph_lo = ph; a.ph_hi = ph + 1; hipLaunchKernelGGL(fwd_kernel, dim3(grid), dim3(NTHR), LDS_BYTES, stream, a); }
#endif
}
```
